# Optimizing an MI355X kernel written in HIP

```python
import math
import jax, jax.numpy as jnp
from jax import lax
import numpy as np


D_MODEL = 4096
BATCH = 8
SEQ = 2048
DEPTH = 2
DEC_BATCH = 4
DEC_SEQ = 4096
PAST_LEN = 128

A_GROUPS = 4
A_GROUP_DIM = D_MODEL // 8
A_WIDTH = A_GROUPS * A_GROUP_DIM
B_HEADS = 4
B_DV = D_MODEL // 8
B_DK = B_DV // 2
B_QK_WIDTH = B_HEADS * B_DK
B_V_WIDTH = B_HEADS * B_DV
GATE_RANK = 16
GATE_TEMP = 16.0
GLA_CHUNK = 64
AB_IN = A_WIDTH + 2 * B_QK_WIDTH + 2 * B_V_WIDTH + 2 * GATE_RANK
AB_MIX = A_WIDTH + B_V_WIDTH
C_HEAD_DIM = 64
C_HEADS = D_MODEL // C_HEAD_DIM
C_KV_HEADS = 8
C_IN = (C_HEADS + 2 * C_KV_HEADS) * C_HEAD_DIM
WINDOW = 128
ATTN_BLOCK = 128
N_BUCKETS = 32
MAX_DISTANCE = 128
D_FF = -(-8 * D_MODEL // (3 * 256)) * 256
N_EVEN = (DEPTH + 1) // 2
N_ODD = DEPTH // 2
DEEPNORM_ALPHA = (2 * DEPTH) ** 0.25
DEEPNORM_BETA = (8 * DEPTH) ** -0.25
LN_EPS = 1e-5

kernel_name = 'hybrid_fnet_gla_swa_encoder'


def _standardize(xf):
    mu = jnp.mean(xf, axis=-1, keepdims=True)
    xc = xf - mu
    return xc * lax.rsqrt(jnp.mean(xc * xc, axis=-1, keepdims=True) + LN_EPS)


def layer_norm(x, g, b):
    y = _standardize(x.astype(jnp.float32)) * g.astype(jnp.float32) + b.astype(jnp.float32)
    return y.astype(x.dtype)


def group_norm(xf, g):
    return _standardize(xf.astype(jnp.float32)) * g.astype(jnp.float32)


def t5_bucket(rel):
    nb = N_BUCKETS // 2
    max_exact = nb // 2
    ret = jnp.where(rel > 0, nb, 0)
    n = jnp.abs(rel)
    nf = jnp.maximum(n, 1).astype(jnp.float32)
    large = max_exact + (jnp.log(nf / max_exact) / math.log(MAX_DISTANCE / max_exact)
                         * (nb - max_exact)).astype(jnp.int32)
    large = jnp.minimum(large, nb - 1)
    return ret + jnp.where(n < max_exact, n, large)


def band_bias(table):
    qq = jnp.arange(ATTN_BLOCK)[:, None]
    kk = jnp.arange(3 * ATTN_BLOCK)[None, :]
    rel = kk - ATTN_BLOCK - qq
    return jnp.transpose(table[t5_bucket(rel)], (2, 0, 1)).astype(jnp.float32)


def gla_chunked(q, k, v, log_a):
    B, S, H, dk = q.shape
    dv = v.shape[-1]
    nc = S // GLA_CHUNK

    def to_chunks(t):
        return t.reshape(B, nc, GLA_CHUNK, H, t.shape[-1]).transpose(1, 0, 3, 2, 4)

    qc, kc, vc = to_chunks(q), to_chunks(k), to_chunks(v)
    gc = jnp.cumsum(to_chunks(log_a), axis=3)
    tril = jnp.tril(jnp.ones((GLA_CHUNK, GLA_CHUNK), dtype=bool))

    def step(state, inp):
        q_, k_, v_, g_ = inp
        diff = g_[:, :, :, None, :] - g_[:, :, None, :, :]
        decay = jnp.exp(jnp.where(tril[:, :, None], diff, -jnp.inf))
        scores = jnp.einsum('bhid,bhijd->bhij', q_, decay * k_[:, :, None, :, :])
        o_intra = jnp.einsum('bhij,bhje->bhie', scores, v_)
        o_inter = jnp.einsum('bhid,bhde->bhie', q_ * jnp.exp(g_), state)
        g_last = g_[:, :, -1:, :]
        k_dec = k_ * jnp.exp(g_last - g_)
        state = state * jnp.swapaxes(jnp.exp(g_last), -1, -2) + jnp.einsum('bhjd,bhje->bhde', k_dec, v_)
        return state, o_intra + o_inter

    state0 = jnp.zeros((B, H, dk, dv), jnp.float32)
    _, ys = lax.scan(step, state0, (qc, kc, vc, gc))
    return ys.transpose(1, 0, 3, 2, 4).reshape(B, S, H, dv)


def mixer_ab(x, w_in, fourier_g, gate_w2, gate_b, head_norm_g, w_out):
    B, S, _ = x.shape
    proj = x @ w_in
    sizes = [A_WIDTH, B_QK_WIDTH, B_QK_WIDTH, B_V_WIDTH, B_V_WIDTH, GATE_RANK, GATE_RANK]
    cuts = np.cumsum(sizes)[:-1].tolist()
    u, q, k, v, r, g_fwd, g_bwd = jnp.split(proj, cuts, axis=-1)

    u = group_norm(u.reshape(B, S, A_GROUPS, A_GROUP_DIM), fourier_g)
    a_out = jnp.real(jnp.fft.fft2(u, axes=(1, 3), norm='ortho')).reshape(B, S, A_WIDTH)

    qf = q.astype(jnp.float32).reshape(B, S, B_HEADS, B_DK) * (B_DK ** -0.5)
    kf = k.astype(jnp.float32).reshape(B, S, B_HEADS, B_DK)
    vf = v.astype(jnp.float32).reshape(B, S, B_HEADS, B_DV)

    def log_gate(lr, d):
        z = lr.astype(jnp.float32) @ gate_w2[d].astype(jnp.float32) + gate_b[d].astype(jnp.float32)
        return (jax.nn.log_sigmoid(z) / GATE_TEMP).reshape(B, S, B_HEADS, B_DK)

    la_f = log_gate(g_fwd, 0)
    la_b = log_gate(g_bwd, 1)
    o_f = gla_chunked(qf, kf, vf, la_f)
    o_b = jnp.flip(gla_chunked(jnp.flip(qf, 1), jnp.flip(kf, 1), jnp.flip(vf, 1), jnp.flip(la_b, 1)), 1)
    o = group_norm(o_f + o_b, head_norm_g)
    o = o * jax.nn.silu(r.astype(jnp.float32).reshape(B, S, B_HEADS, B_DV))
    b_out = o.reshape(B, S, B_V_WIDTH)

    mix = jnp.concatenate([a_out, b_out], axis=-1).astype(x.dtype)
    return mix @ w_out


def window_attention(q, k, v, sinks, bias):
    B, S, Hq, dh = q.shape
    Hkv = k.shape[2]
    G = Hq // Hkv
    nb = S // ATTN_BLOCK
    scale = dh ** -0.5
    q = q.astype(jnp.float32)
    k = k.astype(jnp.float32)
    v = v.astype(jnp.float32)

    qb = q.reshape(B, nb, ATTN_BLOCK, Hkv, G, dh).transpose(1, 0, 3, 4, 2, 5)

    def key_blocks(t):
        tp = jnp.pad(t, ((0, 0), (ATTN_BLOCK, ATTN_BLOCK), (0, 0), (0, 0)))
        tp = tp.reshape(B, nb + 2, ATTN_BLOCK, Hkv, dh)
        tb = jnp.concatenate([tp[:, :-2], tp[:, 1:-1], tp[:, 2:]], axis=2)
        return tb.transpose(1, 0, 3, 2, 4)

    kb, vb = key_blocks(k), key_blocks(v)
    rel = jnp.arange(3 * ATTN_BLOCK)[None, :] - ATTN_BLOCK - jnp.arange(ATTN_BLOCK)[:, None]
    band = jnp.abs(rel) <= WINDOW
    bias_g = bias.reshape(Hkv, G, ATTN_BLOCK, 3 * ATTN_BLOCK)
    sink = sinks.astype(jnp.float32).reshape(Hkv, G)[None, :, :, None, None]

    def one_block(args):
        n, qn, kn, vn = args
        s = jnp.einsum('bkgqd,bkjd->bkgqj', qn, kn) * scale + bias_g
        kpos = n * ATTN_BLOCK - ATTN_BLOCK + jnp.arange(3 * ATTN_BLOCK)
        ok = band & ((kpos >= 0) & (kpos < S))[None, :]
        s = jnp.where(ok, s, -jnp.inf)
        m = jnp.maximum(jnp.max(s, axis=-1, keepdims=True), sink)
        p = jnp.exp(s - m)
        denom = jnp.sum(p, axis=-1, keepdims=True) + jnp.exp(sink - m)
        return jnp.einsum('bkgqj,bkjd->bkgqd', p, vn) / denom

    out = lax.map(one_block, (jnp.arange(nb), qb, kb, vb))
    return out.transpose(1, 0, 4, 2, 3, 5).reshape(B, S, Hq * dh)


def mixer_c(x, w_in, sinks, w_out, bias):
    B, S, _ = x.shape
    proj = x @ w_in
    qw = C_HEADS * C_HEAD_DIM
    kw = C_KV_HEADS * C_HEAD_DIM
    q = proj[..., :qw].reshape(B, S, C_HEADS, C_HEAD_DIM)
    k = proj[..., qw:qw + kw].reshape(B, S, C_KV_HEADS, C_HEAD_DIM)
    v = proj[..., qw + kw:].reshape(B, S, C_KV_HEADS, C_HEAD_DIM)
    o = window_attention(q, k, v, sinks, bias)
    return o.astype(x.dtype) @ w_out


def swiglu(x, w1, w3, w2):
    return (jax.nn.silu(x @ w1) * (x @ w3)) @ w2


def _normal(key, shape, scale):
    return jax.random.normal(key, shape, jnp.float32) * scale


def setup_inputs(seed: int = 0) -> dict:
    key = jax.random.key(seed)
    ks = jax.random.split(key, 18)
    return {
        'x_prompt': _normal(ks[0], (BATCH, SEQ, D_MODEL), 1.0),
        'x_sample': _normal(ks[1], (DEC_BATCH, DEC_SEQ, D_MODEL), 1.0),
        'rel_bias_table': _normal(ks[2], (N_BUCKETS, C_HEADS), 0.5),
        'ab_w_in': _normal(ks[3], (N_EVEN, D_MODEL, AB_IN), D_MODEL ** -0.5),
        'ab_fourier_g': 1.0 + _normal(ks[4], (N_EVEN, A_GROUPS, A_GROUP_DIM), 0.05),
        'ab_gate_w2': _normal(ks[5], (N_EVEN, 2, GATE_RANK, B_QK_WIDTH), GATE_RANK ** -0.5),
        'ab_gate_b': _normal(ks[6], (N_EVEN, 2, B_QK_WIDTH), 0.1),
        'ab_head_norm_g': 1.0 + _normal(ks[7], (N_EVEN, B_HEADS, B_DV), 0.05),
        'ab_w_out': _normal(ks[8], (N_EVEN, AB_MIX, D_MODEL), DEEPNORM_BETA * AB_MIX ** -0.5),
        'c_w_in': _normal(ks[9], (N_ODD, D_MODEL, C_IN), D_MODEL ** -0.5),
        'c_sinks': _normal(ks[10], (N_ODD, C_HEADS), 0.5),
        'c_w_out': _normal(ks[11], (N_ODD, C_HEADS * C_HEAD_DIM, D_MODEL), DEEPNORM_BETA * (C_HEADS * C_HEAD_DIM) ** -0.5),
        'ffn_w1': _normal(ks[12], (DEPTH, D_MODEL, D_FF), D_MODEL ** -0.5),
        'ffn_w3': _normal(ks[13], (DEPTH, D_MODEL, D_FF), D_MODEL ** -0.5),
        'ffn_w2': _normal(ks[14], (DEPTH, D_FF, D_MODEL), DEEPNORM_BETA * D_FF ** -0.5),
        'ln_g': 1.0 + _normal(ks[15], (DEPTH, 2, D_MODEL), 0.05),
        'ln_b': _normal(ks[16], (DEPTH, 2, D_MODEL), 0.02),
    }


def reference(x_prompt, x_sample, rel_bias_table, ab_w_in, ab_fourier_g, ab_gate_w2, ab_gate_b,
              ab_head_norm_g, ab_w_out, c_w_in, c_sinks, c_w_out, ffn_w1, ffn_w3, ffn_w2, ln_g, ln_b):
    bias = band_bias(rel_bias_table)

    def trunk(x):
        for i in range(DEPTH):
            j = i // 2
            if i % 2 == 0:
                h = mixer_ab(x, ab_w_in[j], ab_fourier_g[j], ab_gate_w2[j], ab_gate_b[j],
                             ab_head_norm_g[j], ab_w_out[j])
            else:
                h = mixer_c(x, c_w_in[j], c_sinks[j], c_w_out[j], bias)
            x = layer_norm(DEEPNORM_ALPHA * x + h, ln_g[i, 0], ln_b[i, 0])
            f = swiglu(x, ffn_w1[i], ffn_w3[i], ffn_w2[i])
            x = layer_norm(DEEPNORM_ALPHA * x + f, ln_g[i, 1], ln_b[i, 1])
        return x

    y_prompt = trunk(x_prompt)
    y_sample = trunk(x_sample)
    return (y_prompt, y_sample)
```

```cpp
#include <hip/hip_runtime.h>
#include <stdint.h>
#include <stdio.h>

constexpr int D = 4096, M = 32768, MH = 16384, DFF = 11008;
constexpr int AB_IN = 8224, C_IN = 5120;
constexpr float ALPHA = 1.41421356237309515f;
constexpr float LN_EPS = 1e-5f;
constexpr size_t MiB = 1u << 20;
constexpr size_t WS_CTL = 0, CTL_ZERO_BYTES = 3 * MiB;
constexpr size_t WS_STATS = 1 * MiB, WS_CS = 2 * MiB;
constexpr int CS13 = 0, BW13 = 22016, CS13_L1 = 44032, BW13_L1 = 66048, CSC = 88064, BWC = 93184, NYQ = 98304;
constexpr size_t WS_WIN = 3 * MiB, WS_WOUT = 68 * MiB, WS_CIN = 100 * MiB, WS_COUT = 140 * MiB, WS_DFTC = 172 * MiB, WS_DFTP = 173 * MiB, WS_DFTS = 189 * MiB;
constexpr size_t WS_W13 = 253 * MiB, WS_W2 = 425 * MiB, WS_XB = 511 * MiB, WS_ACT = 767 * MiB;
constexpr size_t WS_PROJ = WS_ACT, WS_UN = WS_ACT + 258 * MiB, WS_UCS = WS_ACT + 322 * MiB, WS_QK = WS_ACT + 450 * MiB,
                 WS_O = WS_ACT + 578 * MiB, WS_MIX = WS_ACT + 706 * MiB, WS_KT = WS_ACT + 962 * MiB, WS_PB = WS_ACT + 1026 * MiB, WS_EB = WS_ACT + 1042 * MiB, WS_END0 = WS_ACT + 1044 * MiB;
constexpr size_t WS_HID = WS_ACT;
constexpr size_t WS_W13_L1 = WS_ACT + 700 * MiB, WS_W2_L1 = WS_ACT + 872 * MiB;
constexpr size_t WS_CPROJ = WS_ACT, WS_ATTO = WS_ACT + 320 * MiB;
constexpr size_t WS_NEED = WS_END0;
constexpr int CW_BAR = 4096;
constexpr int NWAVES = 8;
constexpr int RING_OFF = 0, RING_BYTES = 131072;
constexpr int LDS_BYTES = 147456;
constexpr int LDSCTL_OFF = LDS_BYTES - 512, MISC_OFF = LDSCTL_OFF + 320;

#define GAS __attribute__((address_space(1)))
#define LAS __attribute__((address_space(3)))
typedef unsigned short bf16;
typedef unsigned v4u __attribute__((ext_vector_type(4)));
typedef unsigned v2u __attribute__((ext_vector_type(2)));
typedef float f32x4 __attribute__((ext_vector_type(4)));
typedef float f32x2 __attribute__((ext_vector_type(2)));
typedef short bf16x8 __attribute__((ext_vector_type(8)));
#define LDS_WAIT() asm volatile("s_waitcnt lgkmcnt(0)" ::: "memory")
#define VM_WAIT() asm volatile("s_waitcnt vmcnt(0)" ::: "memory")
__device__ __forceinline__ unsigned f2bf(float f) { unsigned u = __builtin_bit_cast(unsigned, f); return (u + 0x7fffu + ((u >> 16) & 1u)) >> 16; }
__device__ __forceinline__ float bf2f(unsigned b) { return __builtin_bit_cast(float, b << 16); }
typedef float f32x2_t __attribute__((ext_vector_type(2))); typedef __bf16 bf16x2_t __attribute__((ext_vector_type(2)));
__device__ __forceinline__ unsigned pk2(float lo, float hi) { f32x2_t v = {lo, hi}; bf16x2_t b = __builtin_convertvector(v, bf16x2_t); return __builtin_bit_cast(unsigned, b); }
template <int CTRL> __device__ __forceinline__ float dpp_add(float x) { const int y = __builtin_amdgcn_update_dpp(0, __builtin_bit_cast(int, x), CTRL, 0xf, 0xf, false); return x + __builtin_bit_cast(float, y); }
__device__ __forceinline__ float sum8(float v) { v = dpp_add<0xB1>(v); v = dpp_add<0x4E>(v); return dpp_add<0x141>(v); }
__device__ __forceinline__ float wave_sum(float v) { v = sum8(v); v = dpp_add<0x140>(v); v += __shfl_xor(v, 16); v += __shfl_xor(v, 32); return v; }
__device__ __forceinline__ float silu_f(float a) { return a * __builtin_amdgcn_rcpf(1.0f + __expf(-a)); }

namespace pg8 {
#define PG8_LAS __attribute__((address_space(3)))
typedef unsigned short bf16_t;
typedef short bf16x8 __attribute__((ext_vector_type(8)));
typedef float f32x4 __attribute__((ext_vector_type(4)));
typedef unsigned u32x4 __attribute__((ext_vector_type(4)));
constexpr int BM = 256, BK = 64, HALF = 128, HTB = HALF * BK * 2  , STAGE_BYTES = 8 * HTB, NXCD = 8, WGM = 4;

__host__ __device__ __forceinline__ int lds_byte(int r, int c) { const int st = (r >> 4) * 2 + (c >> 5), rr = r & 15, cc = c & 31, ob = rr * 64 + cc * 2; return st * 1024 + (ob ^ (((ob >> 9) & 1) << 5)); }
__host__ __device__ __forceinline__ void stage_rc(int b, int& R, int& C) { const int st = b / 1024, sb = b % 1024, swz = sb ^ (((sb >> 9) & 1) << 5); R = (st >> 1) * 16 + swz / 64; C = (st & 1) * 32 + (swz % 64) / 2; }
__host__ __device__ __forceinline__ int perm32(int rho) { const int n = rho >> 4, i = rho & 15; return 8 * (i >> 2) + 4 * n + (i & 3); }

struct Unit { int pm, pn; };
struct Gemm { const bf16_t* A; const bf16_t* Bt; int M, N, K; };

struct StaticOrder {
    int nM, nN, nwg, G, c;
    __host__ __device__ void init(int M, int N, int G_, int c_) { nM = M / BM; nN = N / BM; nwg = nM * nN; G = G_; c = c_; }
    __host__ __device__ bool next(int i, Unit& u) const {
        const long L = (long)i * G + c; if (L >= nwg) return false;
        int wgid = (int)L; { const int q = nwg / NXCD, r = nwg % NXCD, xcd = wgid % NXCD, off = wgid / NXCD; wgid = (xcd < r ? xcd * (q + 1) : r * (q + 1) + (xcd - r) * q) + off; }
        const int nig = WGM * nN, gid = wgid / nig, fm = gid * WGM, gsz = (nM - fm) < WGM ? (nM - fm) : WGM;
        u.pm = fm + ((wgid % nig) % gsz); u.pn = (wgid % nig) / gsz; return true;
    }
    __device__ __forceinline__ void a_ready(const Unit&) const {}
    __device__ __forceinline__ void done(const Unit&) const {}
};

__device__ __forceinline__ unsigned cvt_pk_bf16(float lo, float hi) { unsigned r; asm volatile("v_cvt_pk_bf16_f32 %0, %1, %2" : "=v"(r) : "v"(lo), "v"(hi)); return r; }
struct ReverseOrder : StaticOrder {
    __host__ __device__ bool next(int i, Unit& u) const { if (!StaticOrder::next(i, u)) return false; u.pm = nM - 1 - u.pm; return true; } };
struct FoldOrder : StaticOrder { int lgS;
    __host__ __device__ bool next(int i, Unit& u) const { if (!StaticOrder::next(i, u)) return false; const int S = 1 << lgS; if (((u.pn * BM) & (S - 1)) >= (S >> 1)) u.pm += 2; return true; } };
__device__ __forceinline__ u32x4 pack8(const f32x4& a, const f32x4& b) { u32x4 w; w.x = cvt_pk_bf16(a[0], a[1]); w.y = cvt_pk_bf16(a[2], a[3]); w.z = cvt_pk_bf16(b[0], b[1]); w.w = cvt_pk_bf16(b[2], b[3]); return w; }
struct EpiStoreBf {
    static constexpr bool PERM = true, AFTER_DRAIN = false;
    bf16_t* O; int ldc;
    __device__ __forceinline__ void operator()(const f32x4 (&acc)[2][2][4][2], const Unit& u, int wr, int wc, int fr, int fq) const {
        const int row0 = u.pm * BM + wr * 64 + fr, col0 = u.pn * BM + wc * 32 + 8 * fq;
#pragma unroll
        for (int ai = 0; ai < 2; ++ai)
#pragma unroll
            for (int m = 0; m < 4; ++m) { bf16_t* rowp = O + (size_t)(row0 + ai * HALF + m * 16) * ldc + col0;
#pragma unroll
                for (int bj = 0; bj < 2; ++bj) *(u32x4*)(rowp + bj * HALF) = pack8(acc[ai][bj][m][0], acc[ai][bj][m][1]); }
    }
};
struct EpiF1 {
    static constexpr bool PERM = true, AFTER_DRAIN = false;
    bf16_t* U; int lgS;
    __device__ __forceinline__ void operator()(const f32x4 (&acc)[2][2][4][2], const Unit& u, int wr, int wc, int fr, int fq) const {
        const int row0 = u.pm * BM + wr * 64 + fr, col0 = u.pn * BM + wc * 32 + 8 * fq, S = 1 << lgS;
#pragma unroll
        for (int ai = 0; ai < 2; ++ai)
#pragma unroll
            for (int m = 0; m < 4; ++m) { const int r = row0 + ai * HALF + m * 16;
#pragma unroll
                for (int bj = 0; bj < 2; ++bj) { const int c = col0 + bj * HALF, z = c >> lgS, k = c & (S - 1);
                    *(u32x4*)(U + ((size_t)z * 512 + (r & 511)) * S + k) = pack8(acc[ai][bj][m][0], acc[ai][bj][m][1]); } }
    }
};
struct EpiF2 {
    static constexpr bool PERM = true, AFTER_DRAIN = false;
    bf16_t* mix; int S; const float* nyq;
    __device__ __forceinline__ void operator()(const f32x4 (&acc)[2][2][4][2], const Unit& u, int wr, int wc, int fr, int fq) const {
        const int row0 = u.pm * BM + wr * 64 + fr, col0 = u.pn * BM + wc * 32 + 8 * fq;
        f32x4 ny[2][2];
#pragma unroll
        for (int bj = 0; bj < 2; ++bj)
#pragma unroll
            for (int n = 0; n < 2; ++n) ny[bj][n] = *(const f32x4*)(nyq + col0 + bj * HALF + 4 * n);
#pragma unroll
        for (int ai = 0; ai < 2; ++ai)
#pragma unroll
            for (int m = 0; m < 4; ++m) { const int r = row0 + ai * HALF + m * 16; const float sg = (r & 1) ? -1.0f : 1.0f;
#pragma unroll
                for (int bj = 0; bj < 2; ++bj) { const int c = col0 + bj * HALF, z = c >> 9, cp = c & 511, b = z >> 2, g = z & 3;
                    const u32x4 w = pack8(acc[ai][bj][m][0] + ny[bj][0] * sg, acc[ai][bj][m][1] + ny[bj][1] * sg);
                    *(u32x4*)(mix + ((size_t)b * S + r) * 4096 + g * 512 + cp) = w;
                    if (r != 0) { bf16_t* mr = mix + ((size_t)b * S + (S - r)) * 4096 + g * 512;
                        const int A = (504 - cp) & 511;
                        typedef unsigned u32x2 __attribute__((ext_vector_type(2)));
                        mr[A + 1] = (bf16_t)(w.w >> 16);
                        *(unsigned*)(mr + A + 2) = (w.w & 0xffffu) | (w.z & 0xffff0000u);
                        *(u32x2*)(mr + A + 4) = (u32x2){(w.z & 0xffffu) | (w.y & 0xffff0000u), (w.y & 0xffffu) | (w.x & 0xffff0000u)};
                        mr[(A + 8) & 511] = (bf16_t)(w.x & 0xffffu); } } }
    }
};
__device__ __forceinline__ void row_stats(const float* st, int row, float& mu, float& rstd) { const float s = st[2 * row], ss = st[2 * row + 1]; mu = s * (1.0f / 4096.0f); rstd = rsqrtf(fmaxf(ss * (1.0f / 4096.0f) - mu * mu, 0.f) + 1e-5f); }
template <bool LN_IN> struct EpiResid {
    static constexpr bool PERM = true, AFTER_DRAIN = false;
    const float* x0; const float* x1p; float* outf; const bf16_t* xres; bf16_t* xb; const float* st_in; const float* g_in; const float* b_in; float* st_out; float alpha;
    __device__ __forceinline__ void operator()(const f32x4 (&acc)[2][2][4][2], const Unit& u, int wr, int wc, int fr, int fq) const {
        const int row0 = u.pm * BM + wr * 64 + fr, col0 = u.pn * BM + wc * 32 + 8 * fq;
        const float* xin = (u.pm < 64) ? x0 : x1p;
        f32x4 gv[2][2], bv[2][2];
        if (LN_IN) {
#pragma unroll
            for (int bj = 0; bj < 2; ++bj)
#pragma unroll
                for (int n = 0; n < 2; ++n) { gv[bj][n] = *(const f32x4*)(g_in + col0 + bj * HALF + 4 * n); bv[bj][n] = *(const f32x4*)(b_in + col0 + bj * HALF + 4 * n); } }
#pragma unroll
        for (int ai = 0; ai < 2; ++ai)
#pragma unroll
            for (int mp = 0; mp < 2; ++mp) {
                f32x4 xv[2][2][2]; float mu[2] = {0.f, 0.f}, rstd[2] = {1.f, 1.f};
                u32x4 wraw[2][2]; ::f32x2 sraw[2];
#pragma unroll
                for (int mm = 0; mm < 2; ++mm) { const int row = row0 + ai * HALF + (2 * mp + mm) * 16; const size_t off = (size_t)row * 4096 + col0;
#pragma unroll
                    for (int bj = 0; bj < 2; ++bj) {
                        if (LN_IN) wraw[mm][bj] = *(const u32x4*)(xres + off + bj * HALF);
                        else { xv[mm][bj][0] = *(const f32x4*)(xin + off + bj * HALF); xv[mm][bj][1] = *(const f32x4*)(xin + off + bj * HALF + 4); } }
                    if (LN_IN) sraw[mm] = *(const ::f32x2*)(st_in + 2 * row); }
                asm volatile("" ::: "memory");
                if (LN_IN) {
#pragma unroll
                    for (int mm = 0; mm < 2; ++mm) {
#pragma unroll
                        for (int bj = 0; bj < 2; ++bj) { const u32x4 w = wraw[mm][bj];
                            xv[mm][bj][0] = (f32x4){__builtin_bit_cast(float, w.x << 16), __builtin_bit_cast(float, w.x & 0xffff0000u), __builtin_bit_cast(float, w.y << 16), __builtin_bit_cast(float, w.y & 0xffff0000u)};
                            xv[mm][bj][1] = (f32x4){__builtin_bit_cast(float, w.z << 16), __builtin_bit_cast(float, w.z & 0xffff0000u), __builtin_bit_cast(float, w.w << 16), __builtin_bit_cast(float, w.w & 0xffff0000u)}; }
                        const float m_ = sraw[mm].x * (1.0f / 4096.0f); mu[mm] = m_; rstd[mm] = rsqrtf(fmaxf(sraw[mm].y * (1.0f / 4096.0f) - m_ * m_, 0.f) + 1e-5f); } }
#pragma unroll
                for (int mm = 0; mm < 2; ++mm) { const int m = 2 * mp + mm, row = row0 + ai * HALF + m * 16; const size_t off = (size_t)row * 4096 + col0;
                    float rs = 0.f, rss = 0.f;
#pragma unroll
                    for (int bj = 0; bj < 2; ++bj) { f32x4 v[2];
#pragma unroll
                        for (int n = 0; n < 2; ++n) { f32x4 x = xv[mm][bj][n];
                            if (LN_IN) x = (x - mu[mm]) * rstd[mm] * gv[bj][n] + bv[bj][n];
                            v[n] = x * alpha + acc[ai][bj][m][n];
                            rs += (v[n][0] + v[n][1]) + (v[n][2] + v[n][3]); rss += (v[n][0] * v[n][0] + v[n][1] * v[n][1]) + (v[n][2] * v[n][2] + v[n][3] * v[n][3]); }
                        if (outf) { *(f32x4*)(outf + off + bj * HALF) = v[0]; *(f32x4*)(outf + off + bj * HALF + 4) = v[1]; }
                        if (xb) *(u32x4*)(xb + off + bj * HALF) = pack8(v[0], v[1]); }
                    if (st_out) { rs += __shfl_xor(rs, 16); rss += __shfl_xor(rss, 16); rs += __shfl_xor(rs, 32); rss += __shfl_xor(rss, 32);
                        if (fq == 0) { atomicAdd(st_out + 2 * row, rs); atomicAdd(st_out + 2 * row + 1, rss); } } }
            }
    }
};
struct EpiStoreBfFold {
    static constexpr bool PERM = true, AFTER_DRAIN = false;
    bf16_t* O; int ldc; const float* st; const float* cs; const float* bw;
    __device__ __forceinline__ void operator()(const f32x4 (&acc)[2][2][4][2], const Unit& u, int wr, int wc, int fr, int fq) const {
        const int row0 = u.pm * BM + wr * 64 + fr, col0 = u.pn * BM + wc * 32 + 8 * fq;
        f32x4 c4[2][2], b4[2][2];
#pragma unroll
        for (int bj = 0; bj < 2; ++bj)
#pragma unroll
            for (int n = 0; n < 2; ++n) { c4[bj][n] = *(const f32x4*)(cs + col0 + bj * HALF + 4 * n); b4[bj][n] = *(const f32x4*)(bw + col0 + bj * HALF + 4 * n); }
        float mus[2][4], rsd[2][4];
        { ::f32x2 raw[2][4];
#pragma unroll
        for (int ai = 0; ai < 2; ++ai)
#pragma unroll
            for (int m = 0; m < 4; ++m) raw[ai][m] = *(const ::f32x2*)(st + 2 * (row0 + ai * HALF + m * 16));
        asm volatile("" ::: "memory");
#pragma unroll
        for (int ai = 0; ai < 2; ++ai)
#pragma unroll
            for (int m = 0; m < 4; ++m) { const float mu = raw[ai][m].x * (1.0f / 4096.0f); mus[ai][m] = mu; rsd[ai][m] = rsqrtf(fmaxf(raw[ai][m].y * (1.0f / 4096.0f) - mu * mu, 0.f) + 1e-5f); } }
#pragma unroll
        for (int ai = 0; ai < 2; ++ai)
#pragma unroll
            for (int m = 0; m < 4; ++m) { const int row = row0 + ai * HALF + m * 16; const float mu = mus[ai][m], rstd = rsd[ai][m];
                bf16_t* rowp = O + (size_t)row * ldc + col0;
#pragma unroll
                for (int bj = 0; bj < 2; ++bj) { const f32x4 y0 = (acc[ai][bj][m][0] - c4[bj][0] * mu) * rstd + b4[bj][0], y1 = (acc[ai][bj][m][1] - c4[bj][1] * mu) * rstd + b4[bj][1];
                    *(u32x4*)(rowp + bj * HALF) = pack8(y0, y1); } }
    }
};
struct EpiSwiGLU {
    static constexpr bool PERM = true, AFTER_DRAIN = false;
    bf16_t* H; int ldh; const float* st; const float* cs; const float* bw;
    __device__ __forceinline__ void operator()(const f32x4 (&acc)[2][2][4][2], const Unit& u, int wr, int wc, int fr, int fq) const {
        const int row0 = u.pm * BM + wr * 64 + fr, col0 = u.pn * HALF + wc * 32 + 8 * fq, cb = u.pn * BM + wc * 32 + 8 * fq;
        f32x4 c4[2][2], b4[2][2];
#pragma unroll
        for (int bj = 0; bj < 2; ++bj)
#pragma unroll
            for (int n = 0; n < 2; ++n) { c4[bj][n] = *(const f32x4*)(cs + cb + bj * HALF + 4 * n); b4[bj][n] = *(const f32x4*)(bw + cb + bj * HALF + 4 * n); }
        float mus[2][4], rsd[2][4];
        { ::f32x2 raw[2][4];
#pragma unroll
        for (int ai = 0; ai < 2; ++ai)
#pragma unroll
            for (int m = 0; m < 4; ++m) raw[ai][m] = *(const ::f32x2*)(st + 2 * (row0 + ai * HALF + m * 16));
        asm volatile("" ::: "memory");
#pragma unroll
        for (int ai = 0; ai < 2; ++ai)
#pragma unroll
            for (int m = 0; m < 4; ++m) { const float mu = raw[ai][m].x * (1.0f / 4096.0f); mus[ai][m] = mu; rsd[ai][m] = rsqrtf(fmaxf(raw[ai][m].y * (1.0f / 4096.0f) - mu * mu, 0.f) + 1e-5f); } }
#pragma unroll
        for (int ai = 0; ai < 2; ++ai)
#pragma unroll
            for (int m = 0; m < 4; ++m) { const int row = row0 + ai * HALF + m * 16; const float mu = mus[ai][m], rstd = rsd[ai][m];
                f32x4 h[2];
                f32x4 a1[2], a3[2], e[2];
#pragma unroll
                for (int n = 0; n < 2; ++n) { a1[n] = (acc[ai][0][m][n] - c4[0][n] * mu) * rstd + b4[0][n]; a3[n] = (acc[ai][1][m][n] - c4[1][n] * mu) * rstd + b4[1][n]; e[n] = a1[n] * -1.4426950408889634f; }
#pragma unroll
                for (int n = 0; n < 2; ++n)
#pragma unroll
                    for (int j = 0; j < 4; ++j) e[n][j] = __builtin_amdgcn_exp2f(e[n][j]);
                asm volatile("" : "+v"(e[0]), "+v"(e[1]));
                e[0] = e[0] + 1.0f; e[1] = e[1] + 1.0f;
#pragma unroll
                for (int n = 0; n < 2; ++n)
#pragma unroll
                    for (int j = 0; j < 4; ++j) e[n][j] = __builtin_amdgcn_rcpf(e[n][j]);
                asm volatile("" : "+v"(e[0]), "+v"(e[1]));
                h[0] = a1[0] * a3[0] * e[0]; h[1] = a1[1] * a3[1] * e[1];
                *(u32x4*)(H + (size_t)row * ldh + col0) = pack8(h[0], h[1]); }
    }
};
template <class Epi, class Sched, bool ALIGN_EPI = false, bool SP2 = false>
__device__ __forceinline__ void gemm_phase(PG8_LAS unsigned char* lds, const Gemm g, const Sched& S, const Epi& E) {
    int tid_ = threadIdx.x; asm volatile("" : "+v"(tid_));
    const int tid = tid_, wid = __builtin_amdgcn_readfirstlane(tid >> 6), lane = tid & 63, wr = wid >> 2, wc = wid & 3, fr = lane & 15, fq = lane >> 4;
    const int K = g.K, nt = K / BK;
    unsigned voffA[2], voffB[2];
#pragma unroll
    for (int i = 0; i < 2; ++i) { int R, C; stage_rc(tid * 16 + i * 8192, R, C); const int Rb = Epi::PERM ? ((R & ~31) + perm32(R & 31)) : R;
        voffA[i] = (unsigned)(R * K + C) * 2u; voffB[i] = (unsigned)(Rb * K + C) * 2u; }
    const size_t kstep = (size_t)(BK * 2);
    const size_t hstep = (size_t)HALF * K * 2;
    const size_t tstep = 2 * hstep;
    const unsigned ldsw = (unsigned)wid * 1024u;
    const int aoff = lds_byte(wr * 64 + fr, fq * 8), boff = lds_byte(wc * 32 + fr, fq * 8);
#define PG8_SA(b, h) (((b) * 2 + (h)) * HTB)
#define PG8_SB(b, h) ((4 + (b) * 2 + (h)) * HTB)
#define PG8_STAGE(bufoff, gbase, voff) do { _Pragma("unroll") for (int _i = 0; _i < 2; ++_i) \
        __builtin_amdgcn_global_load_lds((const unsigned*)((const char*)(gbase) + (voff)[_i]), (PG8_LAS unsigned*)(lds + (bufoff) + ldsw + _i * 8192), 16, 0, 0); } while (0)
#define PG8_LDA(dst, b, h) do { _Pragma("unroll") for (int m = 0; m < 4; ++m) _Pragma("unroll") for (int k = 0; k < 2; ++k) dst[m][k] = *(const PG8_LAS bf16x8*)(lds + PG8_SA(b, h) + aoff + m * 2048 + k * 1024); } while (0)
#define PG8_LDB(dst, b, h) do { _Pragma("unroll") for (int n = 0; n < 2; ++n) _Pragma("unroll") for (int k = 0; k < 2; ++k) dst[n][k] = *(const PG8_LAS bf16x8*)(lds + PG8_SB(b, h) + boff + n * 2048 + k * 1024); } while (0)
#define PG8_MMA(ai, bj, At, Bt) do { __builtin_amdgcn_s_setprio(1); _Pragma("unroll") for (int m = 0; m < 4; ++m) _Pragma("unroll") for (int n = 0; n < 2; ++n) _Pragma("unroll") for (int k = 0; k < 2; ++k) \
        acc[ai][bj][m][n] = __builtin_amdgcn_mfma_f32_16x16x32_bf16(Bt[n][k], At[m][k], acc[ai][bj][m][n], 0, 0, 0); __builtin_amdgcn_s_setprio(0); } while (0)
#define PG8_WAIT_V(n) asm volatile("s_waitcnt vmcnt(" #n ")" ::: "memory")
#define PG8_WAIT_L(n) asm volatile("s_waitcnt lgkmcnt(" #n ")" ::: "memory")
#define PG8_BAR __builtin_amdgcn_s_barrier()
#define PG8_SCHED __builtin_amdgcn_sched_barrier(0)
    Unit cur, nxt; int ui = 0;
    if (!S.next(0, cur)) return;
    f32x4 acc[2][2][4][2];
#pragma unroll
    for (int a = 0; a < 2; ++a)
#pragma unroll
        for (int b = 0; b < 2; ++b)
#pragma unroll
            for (int m = 0; m < 4; ++m)
#pragma unroll
                for (int n = 0; n < 2; ++n) acc[a][b][m][n] = (f32x4){0.f, 0.f, 0.f, 0.f};
    bf16x8 At[4][2], B0[2][2], B1[2][2];
    const char* cA = (const char*)g.A + (size_t)cur.pm * tstep; const char* cB = (const char*)g.Bt + (size_t)cur.pn * tstep;
    S.a_ready(cur);
    if constexpr (SP2) {
        PG8_STAGE(PG8_SB(0, 0), cB, voffB); PG8_STAGE(PG8_SB(0, 1), cB + hstep, voffB); PG8_STAGE(PG8_SA(0, 0), cA, voffA); PG8_STAGE(PG8_SA(0, 1), cA + hstep, voffA);
        if (wr == 1) PG8_BAR;
        PG8_WAIT_V(2); PG8_BAR;
        PG8_STAGE(PG8_SB(1, 0), cB + kstep, voffB); PG8_STAGE(PG8_SA(1, 0), cA + kstep, voffA); PG8_STAGE(PG8_SB(1, 1), cB + hstep + kstep, voffB);
        PG8_WAIT_V(6); PG8_BAR;
    } else {
        PG8_STAGE(PG8_SB(0, 0), cB, voffB); PG8_STAGE(PG8_SA(0, 0), cA, voffA); PG8_STAGE(PG8_SB(0, 1), cB + hstep, voffB); PG8_STAGE(PG8_SA(0, 1), cA + hstep, voffA);
        if (wr == 1) PG8_BAR;
        PG8_WAIT_V(4); PG8_BAR;
        PG8_STAGE(PG8_SB(1, 0), cB + kstep, voffB); PG8_STAGE(PG8_SA(1, 0), cA + kstep, voffA); PG8_STAGE(PG8_SB(1, 1), cB + hstep + kstep, voffB);
        PG8_WAIT_V(6); PG8_BAR;
    }
    for (;;) {
        const bool has_next = S.next(ui + 1, nxt);
        const char* nA = has_next ? (const char*)g.A + (size_t)nxt.pm * tstep : cA; const char* nB = has_next ? (const char*)g.Bt + (size_t)nxt.pn * tstep : cB;
        for (int t = 0; t < nt; t += 2) {
            const bool last = (t == nt - 2);
            const char* a1 = cA + (size_t)(t + 1) * kstep;
            const char* a2 = last ? nA : cA + (size_t)(t + 2) * kstep; const char* b2 = last ? nB : cB + (size_t)(t + 2) * kstep;
            const char* a3 = a2 + kstep; const char* b3 = b2 + kstep;
            if (last && has_next) S.a_ready(nxt);
            if constexpr (SP2) {
            PG8_LDB(B0, 0, 0); PG8_LDB(B1, 0, 1); PG8_SCHED; PG8_LDA(At, 0, 0); PG8_STAGE(PG8_SA(1, 1), a1 + hstep, voffA);
            PG8_WAIT_V(8); PG8_WAIT_L(0); PG8_BAR; PG8_MMA(0, 0, At, B0); PG8_MMA(0, 1, At, B1); PG8_BAR; PG8_SCHED;
            PG8_LDA(At, 0, 1); PG8_STAGE(PG8_SB(0, 0), b2, voffB); PG8_STAGE(PG8_SB(0, 1), b2 + hstep, voffB); PG8_STAGE(PG8_SA(0, 0), a2, voffA);
            PG8_WAIT_V(8); PG8_WAIT_L(0); PG8_BAR; PG8_MMA(1, 0, At, B0); PG8_MMA(1, 1, At, B1); PG8_BAR; PG8_SCHED;
            PG8_LDB(B0, 1, 0); PG8_LDB(B1, 1, 1); PG8_SCHED; PG8_LDA(At, 1, 0); PG8_STAGE(PG8_SA(0, 1), a2 + hstep, voffA);
            PG8_WAIT_V(8); PG8_WAIT_L(0); PG8_BAR; PG8_MMA(0, 0, At, B0); PG8_MMA(0, 1, At, B1); PG8_BAR; PG8_SCHED;
            PG8_LDA(At, 1, 1); PG8_STAGE(PG8_SB(1, 0), b3, voffB); PG8_STAGE(PG8_SB(1, 1), b3 + hstep, voffB); PG8_STAGE(PG8_SA(1, 0), a3, voffA);
            PG8_WAIT_V(8); PG8_WAIT_L(0); PG8_BAR; PG8_MMA(1, 0, At, B0); PG8_MMA(1, 1, At, B1); PG8_BAR; PG8_SCHED;
            } else {
            PG8_LDB(B0, 0, 0); PG8_SCHED; PG8_LDA(At, 0, 0); PG8_STAGE(PG8_SA(1, 1), a1 + hstep, voffA);
            PG8_WAIT_L(8); PG8_BAR; PG8_WAIT_L(0); PG8_MMA(0, 0, At, B0); PG8_BAR; PG8_SCHED;
            PG8_LDB(B1, 0, 1); PG8_STAGE(PG8_SB(0, 0), b2, voffB);
            PG8_BAR; PG8_WAIT_L(0); PG8_MMA(0, 1, At, B1); PG8_BAR;
            PG8_LDA(At, 0, 1); PG8_STAGE(PG8_SA(0, 0), a2, voffA);
            PG8_BAR; PG8_WAIT_L(0); PG8_MMA(1, 0, At, B0); PG8_BAR; PG8_SCHED;
            PG8_STAGE(PG8_SB(0, 1), b2 + hstep, voffB);
            PG8_WAIT_V(6); PG8_BAR; PG8_MMA(1, 1, At, B1); PG8_BAR;
            PG8_LDB(B0, 1, 0); PG8_SCHED; PG8_LDA(At, 1, 0); PG8_STAGE(PG8_SA(0, 1), a2 + hstep, voffA);
            PG8_WAIT_L(8); PG8_BAR; PG8_WAIT_L(0); PG8_MMA(0, 0, At, B0); PG8_BAR; PG8_SCHED;
            PG8_LDB(B1, 1, 1); PG8_STAGE(PG8_SB(1, 0), b3, voffB);
            PG8_BAR; PG8_WAIT_L(0); PG8_MMA(0, 1, At, B1); PG8_BAR;
            PG8_LDA(At, 1, 1); PG8_STAGE(PG8_SA(1, 0), a3, voffA);
            PG8_BAR; PG8_WAIT_L(0); PG8_MMA(1, 0, At, B0); PG8_BAR; PG8_SCHED;
            PG8_STAGE(PG8_SB(1, 1), b3 + hstep, voffB);
            PG8_WAIT_V(6); PG8_BAR; PG8_MMA(1, 1, At, B1); PG8_BAR;
            }
        }
        if constexpr (ALIGN_EPI) { if (wr == 0) PG8_BAR; }
        if constexpr (!Epi::AFTER_DRAIN) { E(acc, cur, wr, wc, fr, fq); S.done(cur); }
        if (!has_next) break;
#pragma unroll
        for (int a = 0; a < 2; ++a)
#pragma unroll
            for (int b = 0; b < 2; ++b)
#pragma unroll
                for (int m = 0; m < 4; ++m)
#pragma unroll
                    for (int n = 0; n < 2; ++n) acc[a][b][m][n] = (f32x4){0.f, 0.f, 0.f, 0.f};
        cur = nxt; cA = nA; cB = nB; ++ui;
        if constexpr (ALIGN_EPI) { if (wr == 1) PG8_BAR; }
    }
    PG8_WAIT_V(0);
    if constexpr (!ALIGN_EPI) { if (wr == 0) PG8_BAR; }
    PG8_BAR;
    if constexpr (Epi::AFTER_DRAIN) { E.fused(acc, cur, wr, wc, fr, fq, lds, wid, lane); S.done(cur); }
#undef PG8_SA
#undef PG8_SB
#undef PG8_STAGE
#undef PG8_LDA
#undef PG8_LDB
#undef PG8_MMA
#undef PG8_WAIT_V
#undef PG8_WAIT_L
#undef PG8_BAR
#undef PG8_SCHED
}
}
#define XB_TMO      128
#define XB_XCNT(j)  (256  + 64 * (j))
#define XB_XSUB(j)  (1280 + 64 * (j))
#define XB_XGEN(j)  (2304 + 64 * (j))
#define XB_TOP      3328
#define XB_TOPGEN   3392
#define XCD_BAR_WORDS 3456
#define XB_SPIN_CAP (1u << 18)

__device__ __forceinline__ unsigned xb_ld(unsigned* p)              { return __hip_atomic_load(p, __ATOMIC_RELAXED, __HIP_MEMORY_SCOPE_AGENT); }
__device__ __forceinline__ unsigned xb_add(unsigned* p, unsigned v) { return __hip_atomic_fetch_add(p, v, __ATOMIC_RELAXED, __HIP_MEMORY_SCOPE_AGENT); }
__device__ __forceinline__ unsigned xb_xcc_id() { return (unsigned)__builtin_amdgcn_s_getreg((3 << 11) | 20) & 0xFu; }
#define XB_SPIN(cond, bar) do { unsigned _sp = 0; while (cond) { __builtin_amdgcn_s_sleep(1); \
    if ((++_sp & 255u) == 0u) { if (xb_ld(&(bar)[XB_TMO])) break; if (_sp > XB_SPIN_CAP) { atomicAdd(&(bar)[XB_TMO], 1u); break; } } } } while (0)

struct XcdBarrier {
    unsigned* bar; unsigned x;
    volatile LAS unsigned* st;
};

__device__ __forceinline__ XcdBarrier xcd_barrier_post(unsigned* bar, volatile LAS unsigned* st) {
    XcdBarrier b; b.bar = bar; b.x = xb_xcc_id(); b.st = st;
    if (threadIdx.x == 0) (void)xb_add(&bar[XB_XCNT(b.x)], 1u);
    return b;
}
__device__ __forceinline__ void xcd_barrier_complete(unsigned* bar, unsigned x, unsigned& nloc, unsigned& nx) {
    const unsigned G = gridDim.x * gridDim.y * gridDim.z;
    unsigned sum, cnt, mine, sp = 0u;
    for (;;) {
        sum = 0u; cnt = 0u; mine = 0u;
#pragma unroll
        for (unsigned j = 0; j < 16; ++j) { const unsigned c = xb_ld(&bar[XB_XCNT(j)]); sum += c; cnt += (c > 0u) ? 1u : 0u; mine = (j == x) ? c : mine; }
        if (sum == G) break;
        __builtin_amdgcn_s_sleep(1);
        if ((++sp & 255u) == 0u) { if (xb_ld(&bar[XB_TMO])) break; if (sp > XB_SPIN_CAP) { atomicAdd(&bar[XB_TMO], 1u); break; } }
    }
    nloc = mine > 0u ? mine : 1u; nx = cnt > 0u ? cnt : 1u;
}

__device__ __forceinline__ void xcd_barrier(const XcdBarrier& b) {
    asm volatile("s_waitcnt vmcnt(0)" ::: "memory");
    __syncthreads();
    if (threadIdx.x == 0) {
        unsigned* bar = b.bar;
        __builtin_amdgcn_s_waitcnt(0);
        unsigned nloc = b.st[0], nx = b.st[1];
        if (nloc == 0u) { xcd_barrier_complete(bar, b.x, nloc, nx); b.st[0] = nloc; b.st[1] = nx; }
        const unsigned old = xb_add(&bar[XB_XSUB(b.x)], 1u);
        const unsigned gen = old / nloc;
        if (old + 1u == (gen + 1u) * nloc) {
            __builtin_amdgcn_fence(__ATOMIC_RELEASE, "agent");
            asm volatile("s_waitcnt vmcnt(0)" ::: "memory");
            const unsigned og = xb_add(&bar[XB_TOP], 1u);
            const unsigned tg = og / nx;
            if (og + 1u == (tg + 1u) * nx) xb_add(&bar[XB_TOPGEN], 1u);
            else XB_SPIN(xb_ld(&bar[XB_TOPGEN]) == tg, bar);
            __builtin_amdgcn_fence(__ATOMIC_ACQUIRE, "agent");
            xb_add(&bar[XB_XGEN(b.x)], 1u);
            asm volatile("s_waitcnt vmcnt(0)" ::: "memory");
        } else {
            XB_SPIN(xb_ld(&bar[XB_XGEN(b.x)]) == gen, bar);
            __builtin_amdgcn_fence(__ATOMIC_ACQUIRE, "agent");
            asm volatile("s_waitcnt vmcnt(0)" ::: "memory");
        }
    }
    __syncthreads();
}
#define OPAQUE(v) asm volatile("" : "+v"(v))
struct Frame {
    LAS unsigned char* lds;
    volatile LAS unsigned* MISC;
    unsigned* ctl;
    int tid, lane, wave, G;
    int gw, NGW;
};
__device__ __forceinline__ void frame_refresh(Frame& F) { int t = threadIdx.x; OPAQUE(t); F.tid = t; F.lane = t & 63; }

template <bool FOLD>
__device__ __forceinline__ void p0_process_item(int K, int N, bf16* WT, int G, int which, LAS float* scr, int item, int lane, f32x4 g0, f32x4 g1, f32x4 b0, f32x4 b1, float* cs, float* bw) {
    const int nblk = N / 32, kb = item / nblk, nb = item % nblk, k0 = 64 * kb, n0 = 32 * nb;
    const int c = lane & 7;
    float psA[4], pbA[4]; int rA[4];
#pragma unroll
    for (int j = 0; j < 4; ++j) { const int n = (lane >> 3) + 8 * j; const LAS float* s = scr + (8 * c) * 33 + n;
        float w8[8];
#pragma unroll
        for (int i = 0; i < 8; ++i) w8[i] = s[i * 33];
        float pb = 0.f;
        if (FOLD) {
#pragma unroll
            for (int i = 0; i < 8; ++i) { const float gg = (i < 4) ? g0[i & 3] : g1[i & 3], bb = (i < 4) ? b0[i & 3] : b1[i & 3]; pb += bb * w8[i]; w8[i] *= gg; } }
        v4u o; o.x = pk2(w8[0], w8[1]); o.y = pk2(w8[2], w8[3]); o.z = pk2(w8[4], w8[5]); o.w = pk2(w8[6], w8[7]);
        const int col = n0 + n; const int r = (G == 0) ? col : ((col / G) * 2 * G + which * G + col % G);
        *(GAS v4u*)(WT + (size_t)r * K + k0 + 8 * c) = o;
        if (FOLD) { float ps = 0.f;
#pragma unroll
            for (int i = 0; i < 4; ++i) ps += bf2f(o[i] & 0xffffu) + bf2f(o[i] >> 16);
            psA[j] = sum8(ps); pbA[j] = sum8(pb); rA[j] = r; } }
    if (FOLD) { const int jj = c & 3; const bool isb = (c & 4) != 0;
        const float vs = jj == 0 ? psA[0] : jj == 1 ? psA[1] : jj == 2 ? psA[2] : psA[3], vb = jj == 0 ? pbA[0] : jj == 1 ? pbA[1] : jj == 2 ? pbA[2] : pbA[3];
        const int rr = jj == 0 ? rA[0] : jj == 1 ? rA[1] : jj == 2 ? rA[2] : rA[3];
        atomicAdd((isb ? bw : cs) + rr, isb ? vb : vs); }
}
template <bool FOLD>
__device__ __forceinline__ void cvt_weight_impl(Frame& F, const float* W, int K, int N, bf16* WT, int G, int which, const float* gv, const float* bv, float* cs, float* bw) {
    frame_refresh(F);
    LAS float* scr = (LAS float*)(F.lds + RING_OFF + F.wave * 16384);
    const int nitems = (K / 64) * (N / 32), nblk = N / 32, lane = F.lane;
    float r[32];
    int it = F.gw;
    if (it >= nitems) return;
    { const int kb = it / nblk, nb = it % nblk; const float* src = W + (size_t)(64 * kb + (lane >> 5)) * N + 32 * nb + (lane & 31);
#pragma unroll
        for (int i = 0; i < 32; ++i) r[i] = __builtin_nontemporal_load(src + (size_t)(2 * i) * N);
#pragma unroll
        for (int i = 0; i < 32; ++i) scr[(2 * i + (lane >> 5)) * 33 + (lane & 31)] = r[i]; }
#pragma unroll 1
    for (; it < nitems; it += F.NGW) {
        const int nx = (it + F.NGW < nitems) ? it + F.NGW : it;
        f32x4 g0 = {0.f, 0.f, 0.f, 0.f}, g1 = g0, b0 = g0, b1 = g0;
        if (FOLD) { const int kq = 64 * (it / nblk) + 8 * (lane & 7); g0 = *(const f32x4*)(gv + kq); g1 = *(const f32x4*)(gv + kq + 4); b0 = *(const f32x4*)(bv + kq); b1 = *(const f32x4*)(bv + kq + 4); asm volatile("" ::: "memory"); }
        { const int kb = nx / nblk, nb = nx % nblk; const float* src = W + (size_t)(64 * kb + (lane >> 5)) * N + 32 * nb + (lane & 31);
#pragma unroll
            for (int i = 0; i < 32; ++i) r[i] = __builtin_nontemporal_load(src + (size_t)(2 * i) * N); }
        LDS_WAIT(); asm volatile("" ::: "memory");
        p0_process_item<FOLD>(K, N, WT, G, which, scr, it, lane, g0, g1, b0, b1, cs, bw);
        LDS_WAIT(); asm volatile("" ::: "memory");
#pragma unroll
        for (int i = 0; i < 32; ++i) scr[(2 * i + (lane >> 5)) * 33 + (lane & 31)] = r[i];
    }
}
__device__ __forceinline__ void cvt_weight(Frame& F, const float* W, int K, int N, bf16* WT, int G, int which) { cvt_weight_impl<false>(F, W, K, N, WT, G, which, nullptr, nullptr, nullptr, nullptr); }
__device__ __forceinline__ void cvt_weight_fold(Frame& F, const float* W, int K, int N, bf16* WT, int G, int which, const float* gv, const float* bv, float* cs, float* bw) { cvt_weight_impl<true>(F, W, K, N, WT, G, which, gv, bv, cs, bw); }
__device__ __forceinline__ void cvt_rows_bf16(Frame& F, const float* x, bf16* y, size_t n8) {
    frame_refresh(F);
    for (size_t i = (size_t)blockIdx.x * 512 + F.tid; i < n8; i += (size_t)F.G * 512) {
        const f32x4 a = __builtin_nontemporal_load((const f32x4*)(x + i * 8)), b = __builtin_nontemporal_load((const f32x4*)(x + i * 8 + 4));
        v4u o; o.x = pk2(a[0], a[1]); o.y = pk2(a[2], a[3]); o.z = pk2(b[0], b[1]); o.w = pk2(b[2], b[3]);
        *(v4u*)(y + i * 8) = o;
    }
}
__device__ __forceinline__ void gen_dftc(Frame& F, bf16* Dc) {
    frame_refresh(F);
    for (int i = blockIdx.x * 512 + F.tid; i < 1024 * 512; i += F.G * 512) {
        const int r = i >> 9, c = i & 511, rr = r & 511; const int idx = (rr * c) & 511;
        float s, co; sincospif(2.0f * (float)idx / 512.0f, &s, &co);
        Dc[i] = (bf16)f2bf((r < 512 ? co : s) * 0.04419417382415922f);
    }
}
__device__ __forceinline__ void gen_dfts(Frame& F, bf16* Ds, int lgS) {
    frame_refresh(F);
    const int S = 1 << lgS, H = S >> 1; const float sc = 1.0f / sqrtf((float)S);
    for (size_t i = (size_t)blockIdx.x * 512 + F.tid; i < ((size_t)1 << (2 * lgS - 1)); i += (size_t)F.G * 512) {
        const int sp = (int)(i >> lgS), k = (int)(i & (size_t)(S - 1)), r = k & (H - 1); const int idx = (int)(((long)sp * r) & (S - 1));
        float sn, co; sincospif(2.0f * (float)idx / (float)S, &sn, &co);
        Ds[i] = (bf16)f2bf(k < H ? co * sc : (k == H ? 0.f : -sn * sc));
    }
}

__device__ __forceinline__ void headnorm_phase(Frame& F, const bf16* O, const bf16* proj, const float* hg, bf16* mix) {
    frame_refresh(F);
    for (int t = F.gw; t < MH * 4; t += F.NGW) { const int row = t >> 2, h = t & 3, lane = F.lane;
        const v4u of = *(const v4u*)(O + (size_t)row * 2048 + h * 512 + lane * 8), ob = *(const v4u*)(O + (size_t)MH * 2048 + (size_t)row * 2048 + h * 512 + lane * 8);
        float v[8];
#pragma unroll
        for (int j = 0; j < 4; ++j) { v[2 * j] = bf2f(of[j] & 0xffffu) + bf2f(ob[j] & 0xffffu); v[2 * j + 1] = bf2f(of[j] >> 16) + bf2f(ob[j] >> 16); }
        float s = 0.f;
#pragma unroll
        for (int j = 0; j < 8; ++j) s += v[j];
        const float mean = wave_sum(s) * (1.0f / 512.0f); float q = 0.f;
#pragma unroll
        for (int j = 0; j < 8; ++j) { v[j] -= mean; q += v[j] * v[j]; }
        const float rstd = rsqrtf(wave_sum(q) * (1.0f / 512.0f) + LN_EPS);
        const v4u rr = *(const v4u*)(proj + (size_t)row * 8192 + 6144 + h * 512 + lane * 8);
        const f32x4 g0 = *(const f32x4*)(hg + h * 512 + lane * 8), g1 = *(const f32x4*)(hg + h * 512 + lane * 8 + 4);
        float o[8];
#pragma unroll
        for (int j = 0; j < 8; ++j) { const float r = bf2f((j & 1) ? (rr[j >> 1] >> 16) : (rr[j >> 1] & 0xffffu)); const float gv = (j < 4) ? g0[j & 3] : g1[j & 3]; o[j] = v[j] * rstd * gv * silu_f(r); }
        v4u w; w.x = pk2(o[0], o[1]); w.y = pk2(o[2], o[3]); w.z = pk2(o[4], o[5]); w.w = pk2(o[6], o[7]);
        *(v4u*)(mix + (size_t)row * D + 2048 + h * 512 + lane * 8) = w; }
}
__device__ __forceinline__ void f2_mid_row(Frame& F, const bf16* B2, const float* nyq, bf16* mix, int S, int nz) {
    frame_refresh(F);
    const float isq = rsqrtf((float)S);
    for (int t = F.gw; t < nz * 512; t += F.NGW) { const int z = t >> 9, cp = t & 511, b = z >> 2, g = z & 3;
        const bf16* rp = B2 + (size_t)t * S; float acc = 0.f;
        for (int k0 = F.lane * 8; k0 < (S >> 1); k0 += 512) { const v4u w = *(const v4u*)(rp + k0);
            acc += (bf2f(w.x & 0xffffu) - bf2f(w.x >> 16)) + (bf2f(w.y & 0xffffu) - bf2f(w.y >> 16)) + (bf2f(w.z & 0xffffu) - bf2f(w.z >> 16)) + (bf2f(w.w & 0xffffu) - bf2f(w.w >> 16)); }
        acc = wave_sum(acc);
        if (F.lane == 0) mix[((size_t)b * S + (S >> 1)) * D + g * 512 + cp] = (bf16)f2bf(acc * isq + nyq[t]); }
}
__device__ __forceinline__ void ln_phase(Frame& F, const float* xin, float* x, const float* g, const float* bta, bf16* xb) {
    frame_refresh(F);
    for (int row = F.gw; row < M; row += F.NGW) { const int lane = F.lane;
        float* xr = x + (size_t)row * D; const float* xi = xin + (size_t)row * D;
        f32x4 v[16]; float s = 0.f;
#pragma unroll
        for (int j = 0; j < 16; ++j) { v[j] = __builtin_nontemporal_load((const f32x4*)(xi + j * 256 + lane * 4)); s += (v[j][0] + v[j][1]) + (v[j][2] + v[j][3]); }
        const float mean = wave_sum(s) * (1.0f / D); float q = 0.f;
#pragma unroll
        for (int j = 0; j < 16; ++j) { v[j] = v[j] - mean; q += (v[j][0] * v[j][0] + v[j][1] * v[j][1]) + (v[j][2] * v[j][2] + v[j][3] * v[j][3]); }
        const float rstd = rsqrtf(wave_sum(q) * (1.0f / D) + LN_EPS);
#pragma unroll
        for (int j = 0; j < 16; ++j) { const int c = j * 256 + lane * 4; const f32x4 gg = *(const f32x4*)(g + c), bb = *(const f32x4*)(bta + c);
            const f32x4 o = v[j] * rstd * gg + bb; __builtin_nontemporal_store(o, (f32x4*)(xr + c));
            if (xb) { v2u w; w.x = pk2(o[0], o[1]); w.y = pk2(o[2], o[3]); *(v2u*)(xb + (size_t)row * D + c) = w; } } }
}
__device__ __forceinline__ int t5_bucket(int rel) {
    const int n = rel < 0 ? -rel : rel; int b;
    if (n < 8) b = n; else if (n < 12) b = 8; else if (n < 16) b = 9; else if (n < 23) b = 10; else if (n < 32) b = 11; else if (n < 46) b = 12; else if (n < 64) b = 13; else if (n < 91) b = 14; else b = 15;
    return b + (rel > 0 ? 16 : 0);
}
typedef float f32x16 __attribute__((ext_vector_type(16)));
#define MFMA32(a, b, c) __builtin_amdgcn_mfma_f32_32x32x16_bf16((a), (b), (c), 0, 0, 0)
__device__ __forceinline__ int crow(int r, int hh) { return (r & 3) + 8 * (r >> 2) + 4 * hh; }
__device__ __forceinline__ void p2_phase(Frame& F, const bf16* xbh, const bf16* Wg, const float* w2, const float* gb, const bf16* proj, const float* fg, bf16* un,
                                         bf16* QK, bf16* KT, bf16* PB, float* EB, const bf16* Dc, float* nyq, int S) {
    frame_refresh(F);
    LAS float* lrp = (LAS float*)(F.lds + RING_OFF);
    for (int cu = blockIdx.x; cu < MH / 64; cu += F.G) {
        const int row0 = cu * 64;
        { const int rt = F.wave & 3, kh = F.wave >> 2, fr = F.lane & 15, fq = F.lane >> 4;
          const bf16* ap = xbh + (size_t)(row0 + rt * 16 + fr) * D + kh * 2048 + 8 * fq;
          const bf16* bp0 = Wg + (size_t)fr * D + kh * 2048 + 8 * fq; const bf16* bp1 = bp0 + (size_t)16 * D;
          f32x4 a0 = (f32x4){0.f, 0.f, 0.f, 0.f}, a1 = a0;
#pragma unroll 1
          for (int k8 = 0; k8 < 8; ++k8) { bf16x8 av[8], b0[8], b1[8];
#pragma unroll
              for (int ks = 0; ks < 8; ++ks) { av[ks] = *(const bf16x8*)(ap + (k8 * 8 + ks) * 32); b0[ks] = *(const bf16x8*)(bp0 + (k8 * 8 + ks) * 32); b1[ks] = *(const bf16x8*)(bp1 + (k8 * 8 + ks) * 32); }
#pragma unroll
              for (int ks = 0; ks < 8; ++ks) { a0 = __builtin_amdgcn_mfma_f32_16x16x32_bf16(av[ks], b0[ks], a0, 0, 0, 0); a1 = __builtin_amdgcn_mfma_f32_16x16x32_bf16(av[ks], b1[ks], a1, 0, 0, 0); } }
#pragma unroll
          for (int j = 0; j < 4; ++j) { lrp[kh * 2048 + (rt * 16 + 4 * fq + j) * 32 + fr] = a0[j]; lrp[kh * 2048 + (rt * 16 + 4 * fq + j) * 32 + 16 + fr] = a1[j]; } }
        __syncthreads();
        for (int i = F.tid; i < 2048; i += 512) lrp[i] += lrp[2048 + i];
        __syncthreads();
        { const int ch = 2 * F.tid;
#pragma unroll 1
          for (int dir = 0; dir < 2; ++dir) {
              f32x2 w[16];
#pragma unroll
              for (int r = 0; r < 16; ++r) w[r] = *(const f32x2*)(w2 + (dir * 16 + r) * 1024 + ch);
              const f32x2 bb = *(const f32x2*)(gb + dir * 1024 + ch);
              bf16* Qd = QK + (size_t)dir * 2 * MH * 1024; bf16* Kd = Qd + (size_t)MH * 1024;
              bf16* KTc = KT + (((size_t)dir * (MH / 64) + cu) * 1024 + ch) * 64;
              f32x2 g = (f32x2){0.f, 0.f};
              unsigned qn8[8], kn8[8];
#pragma unroll
              for (int ii = 0; ii < 8; ++ii) { const int row = dir ? 63 - ii : ii;
                  qn8[ii] = *(const unsigned*)(proj + (size_t)(row0 + row) * 8192 + 2048 + ch); kn8[ii] = *(const unsigned*)(proj + (size_t)(row0 + row) * 8192 + 3072 + ch); }
              auto gate_group = [&](const int i8) {
                  unsigned kt0[8], kt1[8], qv8[8], kv8[8];
#pragma unroll
                  for (int ii = 0; ii < 8; ++ii) { qv8[ii] = qn8[ii]; kv8[ii] = kn8[ii]; }
                  { const int gn = i8 < 7 ? i8 + 1 : 7;
#pragma unroll
                      for (int ii = 0; ii < 8; ++ii) { const int rs = gn * 8 + ii, row = dir ? 63 - rs : rs;
                          qn8[ii] = *(const unsigned*)(proj + (size_t)(row0 + row) * 8192 + 2048 + ch); kn8[ii] = *(const unsigned*)(proj + (size_t)(row0 + row) * 8192 + 3072 + ch); } }
#pragma unroll
                  for (int ii = 0; ii < 8; ++ii) {
                      const int rs = i8 * 8 + ii, row = dir ? 63 - rs : rs;
                      f32x2 z = bb;
#pragma unroll
                      for (int r = 0; r < 16; ++r) { const float l = lrp[row * 32 + dir * 16 + r]; z += w[r] * l; }
                      g.x += (fminf(z.x, 0.f) - 0.6931471805599453f * __builtin_amdgcn_logf(1.0f + __builtin_amdgcn_exp2f(-1.4426950408889634f * fabsf(z.x)))) * 0.0625f; g.y += (fminf(z.y, 0.f) - 0.6931471805599453f * __builtin_amdgcn_logf(1.0f + __builtin_amdgcn_exp2f(-1.4426950408889634f * fabsf(z.y)))) * 0.0625f;
                      const float e0 = __expf(g.x), e1 = __expf(g.y), i0 = __builtin_amdgcn_rcpf(e0), i1 = __builtin_amdgcn_rcpf(e1);
                      const unsigned qv = qv8[ii], kv = kv8[ii];
                      const float q0 = bf2f(qv & 0xffffu) * 0.0625f * e0, q1 = bf2f(qv >> 16) * 0.0625f * e1, k0 = bf2f(kv & 0xffffu) * i0, k1 = bf2f(kv >> 16) * i1;
                      const unsigned kb0 = f2bf(k0), kb1 = f2bf(k1);
                      *(unsigned*)(Qd + (size_t)(row0 + row) * 1024 + ch) = pk2(q0, q1);
                      *(unsigned*)(Kd + (size_t)(row0 + row) * 1024 + ch) = kb0 | (kb1 << 16);
                      kt0[ii] = kb0; kt1[ii] = kb1;
                  }
                  v4u o0, o1; const int grp = dir ? 7 - i8 : i8;
                  if (dir == 0) { o0.x = kt0[0] | (kt0[1] << 16); o0.y = kt0[2] | (kt0[3] << 16); o0.z = kt0[4] | (kt0[5] << 16); o0.w = kt0[6] | (kt0[7] << 16);
                                  o1.x = kt1[0] | (kt1[1] << 16); o1.y = kt1[2] | (kt1[3] << 16); o1.z = kt1[4] | (kt1[5] << 16); o1.w = kt1[6] | (kt1[7] << 16); }
                  else          { o0.x = kt0[7] | (kt0[6] << 16); o0.y = kt0[5] | (kt0[4] << 16); o0.z = kt0[3] | (kt0[2] << 16); o0.w = kt0[1] | (kt0[0] << 16);
                                  o1.x = kt1[7] | (kt1[6] << 16); o1.y = kt1[5] | (kt1[4] << 16); o1.z = kt1[3] | (kt1[2] << 16); o1.w = kt1[1] | (kt1[0] << 16); }
                  *(v4u*)(KTc + grp * 8) = o0; *(v4u*)(KTc + 64 + grp * 8) = o1;
              };
              gate_group(0);
#pragma unroll 1
              for (int i8 = 1; i8 < 8; ++i8) gate_group(i8);
              f32x2 eo; eo.x = __expf(g.x); eo.y = __expf(g.y);
              *(f32x2*)(EB + ((size_t)cu * 2 + dir) * 1024 + ch) = eo;
          } }
        VM_WAIT(); __syncthreads();
        { const int dir = F.wave >> 2, hd = F.wave & 3, l31 = F.lane & 31, hh = F.lane >> 5;
          const bf16* Qp = QK + (size_t)dir * 2 * MH * 1024 + (size_t)row0 * 1024 + hd * 256; const bf16* Kp = Qp + (size_t)MH * 1024;
          bf16* Pp = PB + (((size_t)cu * 2 + dir) * 4 + hd) * 4096;
#pragma unroll 1
          for (int t = 0; t < 4; ++t) { const int ti = t >> 1, tj = t & 1;
              f32x16 acc;
#pragma unroll
              for (int r = 0; r < 16; ++r) acc[r] = 0.f;
              const bool dead = dir ? (ti == 1 && tj == 0) : (ti == 0 && tj == 1);
              if (!dead) {
                  const bf16* qa = Qp + (size_t)(32 * ti + l31) * 1024 + 8 * hh; const bf16* ka = Kp + (size_t)(32 * tj + l31) * 1024 + 8 * hh;
#pragma unroll 1
                  for (int k8 = 0; k8 < 2; ++k8) { bf16x8 qf[8], kf[8];
#pragma unroll
                      for (int ks = 0; ks < 8; ++ks) { qf[ks] = *(const bf16x8*)(qa + (k8 * 8 + ks) * 16); kf[ks] = *(const bf16x8*)(ka + (k8 * 8 + ks) * 16); }
#pragma unroll
                      for (int ks = 0; ks < 8; ++ks) acc = MFMA32(kf[ks], qf[ks], acc); } }
              const int i = 32 * ti + l31;
#pragma unroll
              for (int r4 = 0; r4 < 4; ++r4) { const int j0 = 32 * tj + 8 * r4 + 4 * hh; float v[4];
#pragma unroll
                  for (int jj = 0; jj < 4; ++jj) { const int j = j0 + jj; const bool keep = dir ? (j >= i) : (j <= i); v[jj] = keep ? acc[4 * r4 + jj] : 0.f; }
                  v2u o; o.x = pk2(v[0], v[1]); o.y = pk2(v[2], v[3]); *(v2u*)(Pp + i * 64 + j0) = o; }
          } }
        { const int nc = S >> 6, b = cu / nc, c = cu - b * nc, lane = F.lane; const size_t seq0 = (size_t)b * S;
          f32x4 fgv[4][2];
#pragma unroll
          for (int g = 0; g < 4; ++g) { fgv[g][0] = *(const f32x4*)(fg + g * 512 + lane * 8); fgv[g][1] = *(const f32x4*)(fg + g * 512 + lane * 8 + 4); }
          for (int t0 = F.wave * 8; t0 < 128; t0 += NWAVES * 8) {
              v4u ra[8], rb[8];
#pragma unroll
              for (int q4 = 0; q4 < 8; ++q4) { const int t = t0 + q4, r = 32 * c + (t >> 2), g = t & 3, r2 = (S - r) & (S - 1);
                  ra[q4] = *(const v4u*)(proj + (seq0 + r) * 8192 + g * 512 + lane * 8); rb[q4] = *(const v4u*)(proj + (seq0 + r2) * 8192 + g * 512 + lane * 8); }
#pragma unroll
              for (int q4 = 0; q4 < 8; ++q4) { const int t = t0 + q4, r = 32 * c + (t >> 2), g = t & 3;
                  float v1[8], v2[8];
#pragma unroll
                  for (int j = 0; j < 4; ++j) { v1[2 * j] = bf2f(ra[q4][j] & 0xffffu); v1[2 * j + 1] = bf2f(ra[q4][j] >> 16); v2[2 * j] = bf2f(rb[q4][j] & 0xffffu); v2[2 * j + 1] = bf2f(rb[q4][j] >> 16); }
                  float s1 = 0.f, s2 = 0.f;
#pragma unroll
                  for (int j = 0; j < 8; ++j) { s1 += v1[j]; s2 += v2[j]; }
                  const float m1 = wave_sum(s1) * (1.0f / 512.0f), m2 = wave_sum(s2) * (1.0f / 512.0f); float q1 = 0.f, q2 = 0.f;
#pragma unroll
                  for (int j = 0; j < 8; ++j) { v1[j] -= m1; q1 += v1[j] * v1[j]; v2[j] -= m2; q2 += v2[j] * v2[j]; }
                  const float r1 = rsqrtf(wave_sum(q1) * (1.0f / 512.0f) + LN_EPS), r2s = rsqrtf(wave_sum(q2) * (1.0f / 512.0f) + LN_EPS);
                  const f32x4 g0 = fgv[q4 & 3][0], g1 = fgv[q4 & 3][1];
                  float e[8], o[8];
#pragma unroll
                  for (int j = 0; j < 8; ++j) { const float gg = (j < 4) ? g0[j & 3] : g1[j & 3]; const float a1 = v1[j] * r1 * gg, a2 = (r == 0) ? 0.f : v2[j] * r2s * gg; e[j] = a1 + a2; o[j] = a1 - a2; }
                  bf16* fb = un + ((size_t)(b * 4 + g) * S + r) * 512 + lane * 8;
                  v4u we; we.x = pk2(e[0], e[1]); we.y = pk2(e[2], e[3]); we.z = pk2(e[4], e[5]); we.w = pk2(e[6], e[7]);
                  *(v4u*)fb = we;
                  if (r != 0) { v4u wo; wo.x = pk2(o[0], o[1]); wo.y = pk2(o[2], o[3]); wo.z = pk2(o[4], o[5]); wo.w = pk2(o[6], o[7]); *(v4u*)(fb + (size_t)(S >> 1) * 512) = wo; }
              } }
          LAS float* nyl = (LAS float*)(F.lds + RING_OFF + 16384);
          if (F.wave < 4) { const int g = F.wave; const v4u raw = *(const v4u*)(proj + (seq0 + (S >> 1)) * 8192 + g * 512 + lane * 8);
              float v[8];
#pragma unroll
              for (int j = 0; j < 4; ++j) { v[2 * j] = bf2f(raw[j] & 0xffffu); v[2 * j + 1] = bf2f(raw[j] >> 16); }
              float sm = 0.f;
#pragma unroll
              for (int j = 0; j < 8; ++j) sm += v[j];
              const float mean = wave_sum(sm) * (1.0f / 512.0f); float q = 0.f;
#pragma unroll
              for (int j = 0; j < 8; ++j) { v[j] -= mean; q += v[j] * v[j]; }
              const float rstd = rsqrtf(wave_sum(q) * (1.0f / 512.0f) + LN_EPS);
              const f32x4 g0 = *(const f32x4*)(fg + g * 512 + lane * 8), g1 = *(const f32x4*)(fg + g * 512 + lane * 8 + 4);
              f32x4 n0, n1;
#pragma unroll
              for (int j = 0; j < 4; ++j) { n0[j] = v[j] * rstd * g0[j]; n1[j] = v[4 + j] * rstd * g1[j]; }
              *(LAS f32x4*)(nyl + g * 512 + lane * 8) = n0; *(LAS f32x4*)(nyl + g * 512 + lane * 8 + 4) = n1;
              if (c == 0) *(v4u*)(un + ((size_t)(b * 4 + g) * S + (S >> 1)) * 512 + lane * 8) = (v4u){0u, 0u, 0u, 0u}; }
          __syncthreads();
          { const int sl = 512 / nc; const float isq = rsqrtf((float)S);
            for (int idx = F.wave; idx < 4 * sl; idx += NWAVES) { const int g = idx / sl, cp = c * sl + idx % sl;
                const v4u dw = *(const v4u*)(Dc + (size_t)cp * 512 + lane * 8);
                const f32x4 n0 = *(const LAS f32x4*)(nyl + g * 512 + lane * 8), n1 = *(const LAS f32x4*)(nyl + g * 512 + lane * 8 + 4);
                float d = bf2f(dw.x & 0xffffu) * n0[0] + bf2f(dw.x >> 16) * n0[1] + bf2f(dw.y & 0xffffu) * n0[2] + bf2f(dw.y >> 16) * n0[3]
                        + bf2f(dw.z & 0xffffu) * n1[0] + bf2f(dw.z >> 16) * n1[1] + bf2f(dw.w & 0xffffu) * n1[2] + bf2f(dw.w >> 16) * n1[3];
                d = wave_sum(d);
                if (lane == 0) nyq[(b * 4 + g) * 512 + cp] = d * isq; } } }
        __syncthreads();
    }
}

constexpr int GS_VT = 0, GS_VT_P = 72, GS_ST = 9216, GS_ST_P = 264, GS_RED = GS_ST + 64 * GS_ST_P * 2, GS_PL = GS_RED + 16384, GS_PL_P = 72, GS_EL = GS_PL + 64 * GS_PL_P * 2, GS_QL = GS_EL + 1024, GS_QL_P = 264, GS_KL = GS_QL + 64 * GS_QL_P * 2, GS_KL_P = 72, GS_END = GS_KL + 256 * GS_KL_P * 2;
static_assert(GS_RED % 16 == 0 && GS_PL % 16 == 0 && GS_EL % 16 == 0 && GS_QL % 16 == 0 && GS_KL % 16 == 0 && GS_END <= LDSCTL_OFF, "scan LDS map");
#define WG_BAR() do { asm volatile("s_waitcnt lgkmcnt(0)" ::: "memory"); __builtin_amdgcn_s_barrier(); asm volatile("" ::: "memory"); } while (0)
struct ScanOps { v4u pv, pp, pq[4], pk[4]; f32x4 pe; };
__device__ __forceinline__ void scan_load(ScanOps& o, const bf16* proj, const bf16* Qd, const bf16* KTd, const bf16* PB, const float* EB, int cg, int dir, int hd, int slab, int tid, int w, int l31, int hh, int ti, int kh) {
    const int row0 = cg * 64, tok = tid >> 3, c8 = tid & 7;
    o.pv = *(const v4u*)(proj + (size_t)(row0 + tok) * 8192 + 4096 + hd * 512 + slab * 64 + c8 * 8);
    o.pp = *(const v4u*)(PB + (((size_t)cg * 2 + dir) * 4 + hd) * 4096 + tok * 64 + c8 * 8);
    o.pe = *(const f32x4*)(EB + ((size_t)cg * 2 + dir) * 1024 + hd * 256 + 4 * (tid & 63));
#pragma unroll
    for (int i = 0; i < 4; ++i) { const int c = tid + 512 * i; o.pq[i] = *(const v4u*)(Qd + (size_t)(row0 + (c >> 5)) * 1024 + hd * 256 + (c & 31) * 8); }
    const bf16* ka = KTd + ((size_t)cg * 1024 + hd * 256) * 64;
#pragma unroll
    for (int i = 0; i < 4; ++i) o.pk[i] = *(const v4u*)(ka + (size_t)(tid + 512 * i) * 8);
}
__device__ __forceinline__ void gla_scan_phase(Frame& F, const bf16* proj, const bf16* QK, const bf16* KT, const bf16* PB, const float* EB, bf16* O, int S, int nb, int ostride, int hmask) {
    frame_refresh(F);
    LAS bf16* VT = (LAS bf16*)(F.lds + RING_OFF + GS_VT); LAS bf16* ST = (LAS bf16*)(F.lds + RING_OFF + GS_ST); LAS float* RED = (LAS float*)(F.lds + RING_OFF + GS_RED);
    LAS bf16* PL = (LAS bf16*)(F.lds + RING_OFF + GS_PL); LAS float* EL = (LAS float*)(F.lds + RING_OFF + GS_EL); LAS bf16* QL = (LAS bf16*)(F.lds + RING_OFF + GS_QL); LAS bf16* KL = (LAS bf16*)(F.lds + RING_OFF + GS_KL);
    const int nc = S / 64, nunits = nb * 64;
    const int w = F.wave, l31 = F.lane & 31, hh = F.lane >> 5;
    const int t = w & 3, ti = t >> 1, tj = t & 1, kh = w >> 2;
    for (int u = blockIdx.x; u < nunits; u += F.G) {
        const int slab = u & 7, dir = (u >> 3) & 1, hd = (u >> 4) & 3, b = u >> 6;
        const bf16* Qd = QK + (size_t)dir * 2 * MH * 1024; const bf16* KTd = KT + (size_t)dir * (MH / 64) * 1024 * 64;
        f32x16 s0, s1;
#pragma unroll
        for (int r = 0; r < 16; ++r) { s0[r] = 0.f; s1[r] = 0.f; }
        ScanOps cur, nxt;
        f32x16 pend; bf16* pend_op = O; bool have_pend = false;
#pragma unroll
        for (int r = 0; r < 16; ++r) pend[r] = 0.f;
        scan_load(cur, proj, Qd, KTd, PB, EB, b * nc + (dir ? nc - 1 : 0), dir, hd, slab, F.tid, w, l31, hh, ti, kh);
        nxt = cur;
#pragma unroll 1
        for (int step = 0; step < nc; ++step) {
            const int c = dir ? nc - 1 - step : step, cg = b * nc + c, row0 = cg * 64;
            { const int tok = F.tid >> 3, c8 = F.tid & 7;
              v4u rot = cur.pv;
              if (c8 & 4) rot = (v4u){rot[2], rot[3], rot[0], rot[1]};
              if (c8 & 2) rot = (v4u){rot[1], rot[2], rot[3], rot[0]};
              if (c8 & 1) rot = (v4u){__builtin_amdgcn_alignbit(rot[1], rot[0], 16), __builtin_amdgcn_alignbit(rot[2], rot[1], 16), __builtin_amdgcn_alignbit(rot[3], rot[2], 16), __builtin_amdgcn_alignbit(rot[0], rot[3], 16)};
#pragma unroll
              for (int j = 0; j < 8; ++j) { const int e = (j + c8) & 7; VT[(c8 * 8 + e) * GS_VT_P + tok] = (bf16)((j & 1) ? (rot[j >> 1] >> 16) : (rot[j >> 1] & 0xffffu)); }
              *(LAS v4u*)(PL + tok * GS_PL_P + c8 * 8) = cur.pp;
#pragma unroll
              for (int i = 0; i < 4; ++i) { const int c = F.tid + 512 * i; *(LAS v4u*)(QL + (c >> 5) * GS_QL_P + (c & 31) * 8) = cur.pq[i]; *(LAS v4u*)(KL + (c >> 3) * GS_KL_P + (c & 7) * 8) = cur.pk[i]; }
              if (F.tid < 64) *(LAS f32x4*)(EL + 4 * F.tid) = cur.pe; }
#pragma unroll
            for (int r4 = 0; r4 < 4; ++r4) { const int dk = 32 * w + 8 * r4 + 4 * hh;
                v2u o0, o1; o0.x = pk2(s0[4 * r4], s0[4 * r4 + 1]); o0.y = pk2(s0[4 * r4 + 2], s0[4 * r4 + 3]); o1.x = pk2(s1[4 * r4], s1[4 * r4 + 1]); o1.y = pk2(s1[4 * r4 + 2], s1[4 * r4 + 3]);
                *(LAS v2u*)(ST + l31 * GS_ST_P + dk) = o0; *(LAS v2u*)(ST + (32 + l31) * GS_ST_P + dk) = o1; }
            WG_BAR();
            if (kh == 0 && have_pend) {
#pragma unroll
                for (int r = 0; r < 16; ++r) pend_op[(size_t)crow(r, hh) * ostride] = (bf16)f2bf(pend[r]); }
            if (step + 1 < nc) scan_load(nxt, proj, Qd, KTd, PB, EB, b * nc + (dir ? nc - 2 - step : step + 1), dir, hd, slab, F.tid, w, l31, hh, ti, kh);
            f32x16 acc;
#pragma unroll
            for (int r = 0; r < 16; ++r) acc[r] = 0.f;
            { const LAS bf16* sb = ST + (32 * tj + l31) * GS_ST_P + kh * 128 + 8 * hh;
              bf16x8 bs[4];
#pragma unroll
              for (int ks = 0; ks < 4; ++ks) bs[ks] = *(const LAS bf16x8*)(sb + ks * 16);
              const LAS bf16* vb0 = VT + l31 * GS_VT_P + 8 * hh; const LAS bf16* vb1 = VT + (32 + l31) * GS_VT_P + 8 * hh;
              bf16x8 v0[4], v1[4];
#pragma unroll
              for (int ks = 0; ks < 4; ++ks) { v0[ks] = *(const LAS bf16x8*)(vb0 + ks * 16); v1[ks] = *(const LAS bf16x8*)(vb1 + ks * 16); }
              const LAS bf16* qb = QL + (32 * ti + l31) * GS_QL_P + kh * 128 + 8 * hh;
              bf16x8 qs[4];
#pragma unroll
              for (int ks = 0; ks < 4; ++ks) qs[ks] = *(const LAS bf16x8*)(qb + ks * 16);
#pragma unroll
              for (int ks = 0; ks < 4; ++ks) acc = MFMA32(qs[ks], bs[ks], acc);
#pragma unroll
              for (int ks = 0; ks < 4; ++ks) { bs[ks] = *(const LAS bf16x8*)(sb + (ks + 4) * 16); qs[ks] = *(const LAS bf16x8*)(qb + (ks + 4) * 16); }
#pragma unroll
              for (int ks = 0; ks < 4; ++ks) acc = MFMA32(qs[ks], bs[ks], acc);
              { const LAS bf16* kb = KL + (32 * w + l31) * GS_KL_P + 8 * hh;
#pragma unroll
                for (int ks = 0; ks < 4; ++ks) qs[ks] = *(const LAS bf16x8*)(kb + ks * 16); }
#pragma unroll
              for (int ks = 0; ks < 4; ++ks) { s0 = MFMA32(qs[ks], v0[ks], s0); s1 = MFMA32(qs[ks], v1[ks], s1); }
              if (kh == 0) { const LAS bf16* pa = PL + (32 * ti + l31) * GS_PL_P + 8 * hh; bf16x8 pf[4];
#pragma unroll
                  for (int ks = 0; ks < 4; ++ks) pf[ks] = *(const LAS bf16x8*)(pa + ks * 16);
#pragma unroll
                  for (int ks = 0; ks < 4; ++ks) acc = MFMA32(pf[ks], tj ? v1[ks] : v0[ks], acc); }
#pragma unroll
              for (int r4 = 0; r4 < 4; ++r4) { const f32x4 e = *(const LAS f32x4*)(EL + 32 * w + 8 * r4 + 4 * hh);
#pragma unroll
                  for (int jj = 0; jj < 4; ++jj) { s0[4 * r4 + jj] *= e[jj]; s1[4 * r4 + jj] *= e[jj]; } } }
            if (kh == 1) {
#pragma unroll
                for (int r = 0; r < 16; ++r) RED[t * 1024 + r * 64 + F.lane] = acc[r]; }
            WG_BAR();
            if (kh == 0) { pend_op = O + (size_t)dir * MH * 2048 + (size_t)(row0 + 32 * ti) * ostride + (hd & hmask) * 512 + slab * 64 + 32 * tj + l31; have_pend = true;
#pragma unroll
                for (int r = 0; r < 16; ++r) pend[r] = acc[r] + RED[t * 1024 + r * 64 + F.lane]; }
            cur = nxt;
        }
        if (kh == 0 && have_pend) {
#pragma unroll
            for (int r = 0; r < 16; ++r) pend_op[(size_t)crow(r, hh) * ostride] = (bf16)f2bf(pend[r]); }
        WG_BAR();
    }
}
constexpr int AT_KP = 72, AT_VP = 392, AT_BP = 264;
constexpr int AT_K = 0, AT_V = 384 * AT_KP * 2, AT_B = AT_V + 64 * AT_VP * 2, AT_END = AT_B + 8 * AT_BP * 4;
static_assert(AT_V % 16 == 0 && AT_B % 16 == 0 && AT_END <= RING_BYTES, "attention LDS map");
__device__ __forceinline__ unsigned cvtpk(float lo, float hi) { f32x2_t v = {lo, hi}; bf16x2_t b = __builtin_convertvector(v, bf16x2_t); return __builtin_bit_cast(unsigned, b); }
__device__ __forceinline__ void attn_phase(Frame& F, const bf16* cp, const float* table, const float* sinks, bf16* ao) {
    frame_refresh(F);
    LAS bf16* KL = (LAS bf16*)(F.lds + RING_OFF + AT_K); LAS bf16* VT = (LAS bf16*)(F.lds + RING_OFF + AT_V); LAS float* BL = (LAS float*)(F.lds + RING_OFF + AT_B);
    const float L2E = 1.4426950408889634f, C1 = 0.125f * 1.4426950408889634f;
    const int w = F.wave, l31 = F.lane & 31, hh = F.lane >> 5;
    for (int u = blockIdx.x; u < (M / 128) * 8; u += F.G) {
        const int kvh = u & 7, qb = u >> 3, row0 = qb * 128;
        int S, p0; if (row0 < MH) { S = 2048; p0 = row0 & 2047; } else { S = 4096; p0 = (row0 - MH) & 4095; }
        const bool lo_ok = p0 > 0, hi_ok = p0 + 128 < S;
        v4u kvr[6], vvr[6];
#pragma unroll
        for (int it = 0; it < 6; ++it) { const int c = F.tid + 512 * it, wr = c >> 3, c8 = c & 7;
            const bool valid = (wr >= 128 || lo_ok) && (wr < 256 || hi_ok);
            kvr[it] = (v4u){0u, 0u, 0u, 0u}; vvr[it] = kvr[it];
            if (valid) { const bf16* src = cp + (size_t)(row0 - 128 + wr) * C_IN + 4096 + kvh * 64 + c8 * 8; kvr[it] = *(const v4u*)src; vvr[it] = *(const v4u*)(src + 512); } }
#pragma unroll
        for (int it = 0; it < 6; ++it) { const int c = F.tid + 512 * it, wr = c >> 3, c8 = c & 7;
            *(LAS v4u*)(KL + wr * AT_KP + c8 * 8) = kvr[it];
            v4u rot = vvr[it];
            if (c8 & 4) rot = (v4u){rot[2], rot[3], rot[0], rot[1]};
            if (c8 & 2) rot = (v4u){rot[1], rot[2], rot[3], rot[0]};
            if (c8 & 1) rot = (v4u){__builtin_amdgcn_alignbit(rot[1], rot[0], 16), __builtin_amdgcn_alignbit(rot[2], rot[1], 16), __builtin_amdgcn_alignbit(rot[3], rot[2], 16), __builtin_amdgcn_alignbit(rot[0], rot[3], 16)};
#pragma unroll
            for (int j = 0; j < 8; ++j) { const int e = (j + c8) & 7; VT[(c8 * 8 + e) * AT_VP + wr] = (bf16)((j & 1) ? (rot[j >> 1] >> 16) : (rot[j >> 1] & 0xffffu)); } }
        for (int e = F.tid; e < 8 * 257; e += 512) { const int hw = e / 257, t = e - hw * 257; BL[hw * AT_BP + t] = table[t5_bucket(t - 128) * 64 + kvh * 8 + hw] * L2E; }
        const int h = kvh * 8 + w; const float sink2 = sinks[h] * L2E;
        bf16x8 qn[4];
#pragma unroll
        for (int ks = 0; ks < 4; ++ks) qn[ks] = *(const bf16x8*)(cp + (size_t)(row0 + l31) * C_IN + h * 64 + 16 * ks + 8 * hh);
        __syncthreads();
#pragma unroll 1
        for (int qi = 0; qi < 4; ++qi) {
            const int qrow = row0 + 32 * qi + l31;
            bf16x8 qf[4];
#pragma unroll
            for (int ks = 0; ks < 4; ++ks) qf[ks] = qn[ks];
            if (qi < 3) {
#pragma unroll
                for (int ks = 0; ks < 4; ++ks) qn[ks] = *(const bf16x8*)(cp + (size_t)(qrow + 32) * C_IN + h * 64 + 16 * ks + 8 * hh); }
            float m = sink2, lsum = hh ? 0.f : 1.f;
            f32x16 o0, o1;
#pragma unroll
            for (int r = 0; r < 16; ++r) { o0[r] = 0.f; o1[r] = 0.f; }
#pragma unroll 3
            for (int kj = qi; kj <= qi + 8; ++kj) {
                if ((kj < 4 && !lo_ok) || (kj >= 8 && !hi_ok)) continue;
                f32x16 s;
#pragma unroll
                for (int r = 0; r < 16; ++r) s[r] = 0.f;
#pragma unroll
                for (int ks = 0; ks < 4; ++ks) { const bf16x8 kf = *(const LAS bf16x8*)(KL + (32 * kj + l31) * AT_KP + 16 * ks + 8 * hh); s = MFMA32(kf, qf[ks], s); }
                const int tb = 32 * (kj - qi) - l31;
                float mx = -INFINITY;
                if (kj == qi || kj == qi + 8) {
#pragma unroll
                    for (int r = 0; r < 16; ++r) { const int t = tb + crow(r, hh); const int tc = t < 0 ? 0 : (t > 256 ? 256 : t);
                        float x = fmaf(s[r], C1, BL[w * AT_BP + tc]); x = (t == tc) ? x : -INFINITY; s[r] = x; mx = fmaxf(mx, x); }
                } else {
#pragma unroll
                    for (int r = 0; r < 16; ++r) { const float x = fmaf(s[r], C1, BL[w * AT_BP + tb + crow(r, hh)]); s[r] = x; mx = fmaxf(mx, x); }
                }
                mx = fmaxf(mx, __shfl_xor(mx, 32));
                if (__builtin_amdgcn_ballot_w64(mx > m + 8.0f) != 0ull) {
                    const float mn = fmaxf(m, mx), sc = __builtin_amdgcn_exp2f(m - mn); m = mn; lsum *= sc;
#pragma unroll
                    for (int r = 0; r < 16; ++r) { o0[r] *= sc; o1[r] *= sc; }
                }
                float ps = 0.f;
#pragma unroll
                for (int r = 0; r < 16; ++r) { const float p = __builtin_amdgcn_exp2f(s[r] - m); s[r] = p; ps += p; }
                lsum += ps;
#pragma unroll
                for (int s2 = 0; s2 < 2; ++s2) {
                    v4u pw; pw.x = cvtpk(s[8 * s2], s[8 * s2 + 1]); pw.y = cvtpk(s[8 * s2 + 2], s[8 * s2 + 3]); pw.z = cvtpk(s[8 * s2 + 4], s[8 * s2 + 5]); pw.w = cvtpk(s[8 * s2 + 6], s[8 * s2 + 7]);
                    const bf16x8 pb = __builtin_bit_cast(bf16x8, pw);
                    const LAS bf16* v0 = VT + l31 * AT_VP + 32 * kj + 16 * s2 + 4 * hh; const LAS bf16* v1 = v0 + 32 * AT_VP;
                    const v2u a00 = *(const LAS v2u*)v0, a01 = *(const LAS v2u*)(v0 + 8), a10 = *(const LAS v2u*)v1, a11 = *(const LAS v2u*)(v1 + 8);
                    const v4u va0 = (v4u){a00.x, a00.y, a01.x, a01.y}, va1 = (v4u){a10.x, a10.y, a11.x, a11.y};
                    o0 = MFMA32(__builtin_bit_cast(bf16x8, va0), pb, o0); o1 = MFMA32(__builtin_bit_cast(bf16x8, va1), pb, o1);
                }
            }
            const float inv = 1.0f / (lsum + __shfl_xor(lsum, 32));
            bf16* op = ao + (size_t)qrow * D + h * 64 + 4 * hh;
#pragma unroll
            for (int r4 = 0; r4 < 4; ++r4) {
                v2u a, b; a.x = cvtpk(o0[4 * r4] * inv, o0[4 * r4 + 1] * inv); a.y = cvtpk(o0[4 * r4 + 2] * inv, o0[4 * r4 + 3] * inv);
                b.x = cvtpk(o1[4 * r4] * inv, o1[4 * r4 + 1] * inv); b.y = cvtpk(o1[4 * r4 + 2] * inv, o1[4 * r4 + 3] * inv);
                *(v2u*)(op + 8 * r4) = a; *(v2u*)(op + 32 + 8 * r4) = b; }
        }
        __syncthreads();
    }
}
struct Args { const float* in[17]; float* out; unsigned char* ws; int ph_lo, ph_hi; };
constexpr int N_PHASES = 20;
__global__ void __launch_bounds__(NWAVES * 64, 2) mega_fwd(Args args) {
    extern __shared__ __attribute__((aligned(16))) unsigned char lds[];
    Frame F;
    F.lds = (LAS unsigned char*)lds;
    F.MISC = (volatile LAS unsigned*)(F.lds + MISC_OFF);
    F.tid = threadIdx.x; F.lane = F.tid & 63; F.wave = __builtin_amdgcn_readfirstlane(F.tid >> 6);
    F.G = gridDim.x; F.gw = blockIdx.x * NWAVES + F.wave; F.NGW = F.G * NWAVES;
    unsigned char* ws = args.ws;
    F.ctl = (unsigned*)(ws + WS_CTL);
    for (int u = F.tid; u < (LDS_BYTES - LDSCTL_OFF) / 4; u += NWAVES * 64) ((LAS unsigned*)(F.lds + LDSCTL_OFF))[u] = 0u;
    __syncthreads();
    XcdBarrier bar = xcd_barrier_post(F.ctl + CW_BAR, F.MISC + 8);

    const float* x_prompt = args.in[0]; const float* x_sample = args.in[1]; const float* table = args.in[2];
    const float* ab_w_in = args.in[3]; const float* ab_fg = args.in[4]; const float* ab_w2 = args.in[5]; const float* ab_gb = args.in[6];
    const float* ab_hg = args.in[7]; const float* ab_w_out = args.in[8]; const float* c_w_in = args.in[9]; const float* c_sinks = args.in[10];
    const float* c_w_out = args.in[11]; const float* ffn_w1 = args.in[12]; const float* ffn_w3 = args.in[13]; const float* ffn_w2 = args.in[14];
    const float* ln_g = args.in[15]; const float* ln_b = args.in[16];
    float* out = args.out;
    bf16 *Win = (bf16*)(ws + WS_WIN), *Wout = (bf16*)(ws + WS_WOUT), *Cin = (bf16*)(ws + WS_CIN), *Cout = (bf16*)(ws + WS_COUT), *Dc = (bf16*)(ws + WS_DFTC), *DsP = (bf16*)(ws + WS_DFTP), *DsS = (bf16*)(ws + WS_DFTS);
    bf16 *W13 = (bf16*)(ws + WS_W13), *W2 = (bf16*)(ws + WS_W2), *xb = (bf16*)(ws + WS_XB), *W13b = (bf16*)(ws + WS_W13_L1), *W2b = (bf16*)(ws + WS_W2_L1);
    bf16 *proj = (bf16*)(ws + WS_PROJ), *un = (bf16*)(ws + WS_UN), *ucs = (bf16*)(ws + WS_UCS), *mix = (bf16*)(ws + WS_MIX);
    float *EB = (float*)(ws + WS_EB); bf16* O = (bf16*)(ws + WS_O);
    float* stats = (float*)(ws + WS_STATS); float* csv = (float*)(ws + WS_CS);
    bf16 *QK = (bf16*)(ws + WS_QK), *KT = (bf16*)(ws + WS_KT), *PB = (bf16*)(ws + WS_PB);
    bf16 *hid = (bf16*)(ws + WS_HID), *cproj = (bf16*)(ws + WS_CPROJ), *atto = (bf16*)(ws + WS_ATTO);

    const int lo = args.ph_lo, hi = args.ph_hi;
#define IN(k) (lo <= (k) && (k) < hi)
#define SEAM(k) do { if (IN(k) && IN((k) + 1)) xcd_barrier(bar); } while (0)
    typedef pg8::StaticOrder SO;

    if (IN(0)) {
        cvt_rows_bf16(F, x_prompt, xb, (size_t)MH * D / 8);
        cvt_rows_bf16(F, x_sample, xb + (size_t)MH * D, (size_t)MH * D / 8);
        cvt_weight(F, ab_w_in, D, AB_IN, Win, 0, 0);
        cvt_weight(F, ab_w_out, D, D, Wout, 0, 0);
        gen_dftc(F, Dc); gen_dfts(F, DsP, 11); gen_dfts(F, DsS, 12);
        __syncthreads();
    }
    SEAM(0);
#pragma unroll 1
    for (int half = 0; half < 2; ++half) {
        const int pb = 1 + 5 * half;
        const int lgS = half ? 12 : 11, S = 1 << lgS, nb = half ? 4 : 8, nz = nb * 4;
        const bf16* xbh = xb + (size_t)half * MH * D; bf16* mixh = mix + (size_t)half * MH * D; const bf16* Ds = half ? DsS : DsP;
        if (IN(pb)) {
            const bool early = ((int)blockIdx.x & 1) != 0;
#pragma unroll 1
            for (int pass = 0; pass < 2; ++pass) {
                if ((pass == 0) == early) {
                    __syncthreads();
                    if (half == 0) {
                        cvt_weight_fold(F, ffn_w1, D, DFF, W13, 128, 0, ln_g, ln_b, csv + CS13, csv + BW13);
                        cvt_weight_fold(F, ffn_w3, D, DFF, W13, 128, 1, ln_g, ln_b, csv + CS13, csv + BW13);
                    } else {
                        cvt_weight(F, ffn_w2, DFF, D, W2, 0, 0);
                        cvt_weight_fold(F, c_w_in, D, C_IN, Cin, 0, 0, ln_g + D, ln_b + D, csv + CSC, csv + BWC);
                        cvt_weight(F, c_w_out, D, D, Cout, 0, 0);
                    }
                    __syncthreads();
                }
                if (pass == 0) {
                    pg8::Gemm g{xbh, Win, MH, 8192, D}; SO So; So.init(MH, 8192, F.G, (int)blockIdx.x);
                    pg8::EpiStoreBf E{proj, 8192};
                    pg8::gemm_phase<pg8::EpiStoreBf, SO, true, true>(F.lds + RING_OFF, g, So, E);
                }
            }
        }
        SEAM(pb);
        if (IN(pb + 1)) p2_phase(F, xbh, Win + (size_t)8192 * D, ab_w2, ab_gb, proj, ab_fg, un, QK, KT, PB, EB, Dc, csv + NYQ, S);
        SEAM(pb + 1);
        if (IN(pb + 2)) {
            pg8::Gemm g{Dc, un, 1024, nz * S, 512}; pg8::FoldOrder So; So.init(512, nz * S, F.G, (int)blockIdx.x); So.lgS = lgS;
            pg8::EpiF1 E{ucs, lgS};
            pg8::gemm_phase<pg8::EpiF1, pg8::FoldOrder, true, true>(F.lds + RING_OFF, g, So, E);
        }
        SEAM(pb + 2);
        if (IN(pb + 3)) {
            { pg8::Gemm g{Ds, ucs, S / 2, nz * 512, S}; SO So; So.init(S / 2, nz * 512, F.G, (int)blockIdx.x);
            pg8::EpiF2 E{mixh, S, csv + NYQ};
            pg8::gemm_phase<pg8::EpiF2, SO, true, true>(F.lds + RING_OFF, g, So, E);
            __syncthreads(); }
            gla_scan_phase(F, proj, QK, KT, PB, EB, O, S, nb, 2048, 3);
        }
        SEAM(pb + 3);
        if (IN(pb + 4)) { f2_mid_row(F, ucs, csv + NYQ, mixh, S, nz); headnorm_phase(F, O, proj, ab_hg, mixh); }
        SEAM(pb + 4);
    }
#pragma unroll 1
    for (int layer = 0; layer < 2; ++layer) {
        const int ob = layer ? 16 : 11;
        float* st_mix = stats + (size_t)(2 * layer) * 2 * M;
        float* st_ffn = stats + (size_t)1 * 2 * M;
        if (layer == 1) {
            if (IN(14)) {
                pg8::Gemm g{xb, Cin, M, C_IN, D}; SO So; So.init(M, C_IN, F.G, (int)blockIdx.x);
                pg8::EpiStoreBfFold E{cproj, C_IN, st_ffn, csv + CSC, csv + BWC};
                pg8::gemm_phase<pg8::EpiStoreBfFold, SO, true, true>(F.lds + RING_OFF, g, So, E);
            }
            SEAM(14);
            if (IN(15)) attn_phase(F, cproj, table, c_sinks, atto);
            SEAM(15);
        }
        if (IN(ob)) {
            pg8::Gemm g{layer ? atto : mix, layer ? Cout : Wout, M, D, D}; SO So; So.init(M, D, F.G, (int)blockIdx.x);
            if (layer == 0) { pg8::EpiResid<false> E{x_prompt, x_sample - (size_t)MH * D, nullptr, nullptr, xb, nullptr, nullptr, nullptr, st_mix, ALPHA};
                pg8::gemm_phase<pg8::EpiResid<false>, SO, true, true>(F.lds + RING_OFF, g, So, E);
 }
            else { pg8::EpiResid<true> E{nullptr, nullptr, nullptr, xb, xb, st_ffn, ln_g + D, ln_b + D, st_mix, ALPHA};
                pg8::gemm_phase<pg8::EpiResid<true>, SO, true, true>(F.lds + RING_OFF, g, So, E); }
        }
        SEAM(ob);
        if (IN(ob + 1)) {
            const bool early = ((int)blockIdx.x & 1) != 0;
#pragma unroll 1
            for (int pass = 0; pass < 2; ++pass) {
                if ((pass == 0) == early) {
                    __syncthreads();
                    if (layer == 0) {
                        cvt_weight_fold(F, ffn_w1 + (size_t)D * DFF, D, DFF, W13b, 128, 0, ln_g + 2 * D, ln_b + 2 * D, csv + CS13_L1, csv + BW13_L1);
                        cvt_weight_fold(F, ffn_w3 + (size_t)D * DFF, D, DFF, W13b, 128, 1, ln_g + 2 * D, ln_b + 2 * D, csv + CS13_L1, csv + BW13_L1);
                    } else cvt_weight(F, ffn_w2 + (size_t)DFF * D, DFF, D, W2b, 0, 0);
                    __syncthreads();
                }
                if (pass == 0) {
                    pg8::Gemm g{xb, layer ? W13b : W13, M, 2 * DFF, D}; SO So; So.init(M, 2 * DFF, F.G, (int)blockIdx.x);
                    pg8::EpiSwiGLU E{hid, DFF, st_mix, csv + (layer ? CS13_L1 : CS13), csv + (layer ? BW13_L1 : BW13)};
                    pg8::gemm_phase<pg8::EpiSwiGLU, SO, true, true>(F.lds + RING_OFF, g, So, E);
                }
            }
        }
        SEAM(ob + 1);
        if (IN(ob + 2)) {
            pg8::Gemm g{hid, layer ? W2b : W2, M, D, DFF}; pg8::ReverseOrder So; So.init(M, D, F.G, (int)blockIdx.x);
            pg8::EpiResid<true> E{nullptr, nullptr, layer ? out : nullptr, xb, layer ? nullptr : xb, st_mix, ln_g + (size_t)(2 * layer) * D, ln_b + (size_t)(2 * layer) * D, layer ? nullptr : st_ffn, ALPHA};
            pg8::gemm_phase<pg8::EpiResid<true>, pg8::ReverseOrder, true, true>(F.lds + RING_OFF, g, So, E);
        }
        SEAM(ob + 2);
        if (layer == 1) {
            if (IN(19)) ln_phase(F, out, out, ln_g + 3 * D, ln_b + 3 * D, (bf16*)nullptr);
        }
    }
#undef IN
#undef SEAM
}

extern "C" void kernel_launch(void* const* d_in, const int* in_sizes, int n_in, void* d_out, int out_size, void* d_ws, size_t ws_size, hipStream_t stream) {
    static int grid = 0;
    if (grid == 0) {
        if (n_in != 17 || out_size != M * D || ws_size < WS_NEED) { fprintf(stderr, "kernel_launch: unexpected sizes: n_in %d out %d ws %zu (need %zu); nothing launched\n", n_in, out_size, ws_size, (size_t)WS_NEED); grid = -1; return; }
        int dev = 0, cus = 0, per_cu = 0;
        if (hipGetDevice(&dev) != hipSuccess || hipDeviceGetAttribute(&cus, hipDeviceAttributeMultiprocessorCount, dev) != hipSuccess) { fprintf(stderr, "kernel_launch: device query failed\n"); grid = -1; return; }
        if (hipFuncSetAttribute((const void*)mega_fwd, hipFuncAttributeMaxDynamicSharedMemorySize, LDS_BYTES) != hipSuccess) { fprintf(stderr, "kernel_launch: hipFuncSetAttribute failed\n"); grid = -1; return; }
        if (hipOccupancyMaxActiveBlocksPerMultiprocessor(&per_cu, (const void*)mega_fwd, NWAVES * 64, LDS_BYTES) != hipSuccess || per_cu < 1) { fprintf(stderr, "kernel_launch: occupancy query reports %d workgroups per CU\n", per_cu); }
        (void)hipGetLastError();
        grid = cus;
    }
    if (grid < 0) return;
    if (hipMemsetAsync((char*)d_ws + WS_CTL, 0, CTL_ZERO_BYTES, stream) != hipSuccess) { fprintf(stderr, "kernel_launch: memset failed\n"); return; }
    Args a{};
    for (int i = 0; i < 17; ++i) a.in[i] = (const float*)d_in[i];
    a.out = (float*)d_out; a.ws = (unsigned char*)d_ws;
#ifndef MK_SPLIT
    a.ph_lo = 0; a.ph_hi = N_PHASES;
    hipLaunchKernelGGL(mega_fwd, dim3(grid), dim3(NWAVES * 64), LDS_BYTES, stream, a);
#else
    for (int p = 0; p < N_PHASES; ++p) { a.ph_lo = p; a.ph_hi = p + 1; hipLaunchKernelGGL(mega_fwd, dim3(grid), dim3(NWAVES * 64), LDS_BYTES, stream, a); }
#endif
    const hipError_t le = hipPeekAtLastError();
    if (le != hipSuccess) fprintf(stderr, "kernel_launch: launch failed: %s\n", hipGetErrorName(le));
}
```

```cpp
#include <hip/hip_runtime.h>
#include <stdint.h>
#include <stdio.h>

constexpr int D = 4096, M = 32768, MH = 16384, DFF = 11008;
constexpr int AB_IN = 8224, C_IN = 5120;
constexpr float ALPHA = 1.41421356237309515f;
constexpr float LN_EPS = 1e-5f;
constexpr size_t MiB = 1u << 20;
constexpr size_t WS_CTL = 0, CTL_ZERO_BYTES = 3 * MiB;
constexpr size_t WS_STATS = 1 * MiB, WS_CS = 2 * MiB;
constexpr int CS13 = 0, BW13 = 22016, CS13_L1 = 44032, BW13_L1 = 66048, CSC = 88064, BWC = 93184, NYQ = 98304;
constexpr size_t WS_WIN = 3 * MiB, WS_WOUT = 68 * MiB, WS_CIN = 100 * MiB, WS_COUT = 140 * MiB, WS_DFTC = 172 * MiB, WS_DFTP = 173 * MiB, WS_DFTS = 189 * MiB;
constexpr size_t WS_W13 = 253 * MiB, WS_W2 = 425 * MiB, WS_XB = 511 * MiB, WS_ACT = 767 * MiB;
constexpr size_t WS_PROJ = WS_ACT, WS_UN = WS_ACT + 258 * MiB, WS_UCS = WS_ACT + 322 * MiB, WS_QK = WS_ACT + 450 * MiB,
                 WS_O = WS_ACT + 578 * MiB, WS_MIX = WS_ACT + 706 * MiB, WS_KT = WS_ACT + 962 * MiB, WS_PB = WS_ACT + 1026 * MiB, WS_EB = WS_ACT + 1042 * MiB, WS_END0 = WS_ACT + 1044 * MiB;
constexpr size_t WS_HID = WS_ACT;
constexpr size_t WS_W13_L1 = WS_ACT + 700 * MiB, WS_W2_L1 = WS_ACT + 872 * MiB;
constexpr size_t WS_CPROJ = WS_ACT, WS_ATTO = WS_ACT + 320 * MiB;
constexpr size_t WS_NEED = WS_END0;
constexpr int CW_BAR = 4096;
constexpr int NWAVES = 8;
constexpr int RING_OFF = 0, RING_BYTES = 131072;
constexpr int LDS_BYTES = 147456;
constexpr int LDSCTL_OFF = LDS_BYTES - 512, MISC_OFF = LDSCTL_OFF + 320;

#define GAS __attribute__((address_space(1)))
#define LAS __attribute__((address_space(3)))
typedef unsigned short bf16;
typedef unsigned v4u __attribute__((ext_vector_type(4)));
typedef unsigned v2u __attribute__((ext_vector_type(2)));
typedef float f32x4 __attribute__((ext_vector_type(4)));
typedef float f32x2 __attribute__((ext_vector_type(2)));
typedef short bf16x8 __attribute__((ext_vector_type(8)));
#define LDS_WAIT() asm volatile("s_waitcnt lgkmcnt(0)" ::: "memory")
#define VM_WAIT() asm volatile("s_waitcnt vmcnt(0)" ::: "memory")
__device__ __forceinline__ unsigned f2bf(float f) { unsigned u = __builtin_bit_cast(unsigned, f); return (u + 0x7fffu + ((u >> 16) & 1u)) >> 16; }
__device__ __forceinline__ float bf2f(unsigned b) { return __builtin_bit_cast(float, b << 16); }
typedef float f32x2_t __attribute__((ext_vector_type(2))); typedef __bf16 bf16x2_t __attribute__((ext_vector_type(2)));
__device__ __forceinline__ unsigned pk2(float lo, float hi) { f32x2_t v = {lo, hi}; bf16x2_t b = __builtin_convertvector(v, bf16x2_t); return __builtin_bit_cast(unsigned, b); }
template <int CTRL> __device__ __forceinline__ float dpp_add(float x) { const int y = __builtin_amdgcn_update_dpp(0, __builtin_bit_cast(int, x), CTRL, 0xf, 0xf, false); return x + __builtin_bit_cast(float, y); }
__device__ __forceinline__ float sum8(float v) { v = dpp_add<0xB1>(v); v = dpp_add<0x4E>(v); return dpp_add<0x141>(v); }
__device__ __forceinline__ float wave_sum(float v) { v = sum8(v); v = dpp_add<0x140>(v); v += __shfl_xor(v, 16); v += __shfl_xor(v, 32); return v; }
__device__ __forceinline__ float silu_f(float a) { return a * __builtin_amdgcn_rcpf(1.0f + __expf(-a)); }

namespace pg8 {
#define PG8_LAS __attribute__((address_space(3)))
typedef unsigned short bf16_t;
typedef short bf16x8 __attribute__((ext_vector_type(8)));
typedef float f32x4 __attribute__((ext_vector_type(4)));
typedef unsigned u32x4 __attribute__((ext_vector_type(4)));
constexpr int BM = 256, BK = 64, HALF = 128, HTB = HALF * BK * 2  , STAGE_BYTES = 8 * HTB, NXCD = 8, WGM = 4;

__host__ __device__ __forceinline__ int lds_byte(int r, int c) { const int st = (r >> 4) * 2 + (c >> 5), rr = r & 15, cc = c & 31, ob = rr * 64 + cc * 2; return st * 1024 + (ob ^ (((ob >> 9) & 1) << 5)); }
__host__ __device__ __forceinline__ void stage_rc(int b, int& R, int& C) { const int st = b / 1024, sb = b % 1024, swz = sb ^ (((sb >> 9) & 1) << 5); R = (st >> 1) * 16 + swz / 64; C = (st & 1) * 32 + (swz % 64) / 2; }
__host__ __device__ __forceinline__ int perm32(int rho) { const int n = rho >> 4, i = rho & 15; return 8 * (i >> 2) + 4 * n + (i & 3); }

struct Unit { int pm, pn; };
struct Gemm { const bf16_t* A; const bf16_t* Bt; int M, N, K; };

struct StaticOrder {
    int nM, nN, nwg, G, c;
    __host__ __device__ void init(int M, int N, int G_, int c_) { nM = M / BM; nN = N / BM; nwg = nM * nN; G = G_; c = c_; }
    __host__ __device__ bool next(int i, Unit& u) const {
        const long L = (long)i * G + c; if (L >= nwg) return false;
        int wgid = (int)L; { const int q = nwg / NXCD, r = nwg % NXCD, xcd = wgid % NXCD, off = wgid / NXCD; wgid = (xcd < r ? xcd * (q + 1) : r * (q + 1) + (xcd - r) * q) + off; }
        const int nig = WGM * nN, gid = wgid / nig, fm = gid * WGM, gsz = (nM - fm) < WGM ? (nM - fm) : WGM;
        u.pm = fm + ((wgid % nig) % gsz); u.pn = (wgid % nig) / gsz; return true;
    }
    __device__ __forceinline__ void a_ready(const Unit&) const {}
    __device__ __forceinline__ void done(const Unit&) const {}
};

__device__ __forceinline__ unsigned cvt_pk_bf16(float lo, float hi) { unsigned r; asm volatile("v_cvt_pk_bf16_f32 %0, %1, %2" : "=v"(r) : "v"(lo), "v"(hi)); return r; }
struct ReverseOrder : StaticOrder {
    __host__ __device__ bool next(int i, Unit& u) const { if (!StaticOrder::next(i, u)) return false; u.pm = nM - 1 - u.pm; return true; } };
struct FoldOrder : StaticOrder { int lgS;
    __host__ __device__ bool next(int i, Unit& u) const { if (!StaticOrder::next(i, u)) return false; const int S = 1 << lgS; if (((u.pn * BM) & (S - 1)) >= (S >> 1)) u.pm += 2; return true; } };
__device__ __forceinline__ u32x4 pack8(const f32x4& a, const f32x4& b) { u32x4 w; w.x = cvt_pk_bf16(a[0], a[1]); w.y = cvt_pk_bf16(a[2], a[3]); w.z = cvt_pk_bf16(b[0], b[1]); w.w = cvt_pk_bf16(b[2], b[3]); return w; }
struct EpiStoreBf {
    static constexpr bool PERM = true, AFTER_DRAIN = false;
    bf16_t* O; int ldc;
    __device__ __forceinline__ void operator()(const f32x4 (&acc)[2][2][4][2], const Unit& u, int wr, int wc, int fr, int fq) const {
        const int row0 = u.pm * BM + wr * 64 + fr, col0 = u.pn * BM + wc * 32 + 8 * fq;
#pragma unroll
        for (int ai = 0; ai < 2; ++ai)
#pragma unroll
            for (int m = 0; m < 4; ++m) { bf16_t* rowp = O + (size_t)(row0 + ai * HALF + m * 16) * ldc + col0;
#pragma unroll
                for (int bj = 0; bj < 2; ++bj) *(u32x4*)(rowp + bj * HALF) = pack8(acc[ai][bj][m][0], acc[ai][bj][m][1]); }
    }
};
struct EpiF1 {
    static constexpr bool PERM = true, AFTER_DRAIN = false;
    bf16_t* U; int lgS;
    __device__ __forceinline__ void operator()(const f32x4 (&acc)[2][2][4][2], const Unit& u, int wr, int wc, int fr, int fq) const {
        const int row0 = u.pm * BM + wr * 64 + fr, col0 = u.pn * BM + wc * 32 + 8 * fq, S = 1 << lgS;
#pragma unroll
        for (int ai = 0; ai < 2; ++ai)
#pragma unroll
            for (int m = 0; m < 4; ++m) { const int r = row0 + ai * HALF + m * 16;
#pragma unroll
                for (int bj = 0; bj < 2; ++bj) { const int c = col0 + bj * HALF, z = c >> lgS, k = c & (S - 1);
                    *(u32x4*)(U + ((size_t)z * 512 + (r & 511)) * S + k) = pack8(acc[ai][bj][m][0], acc[ai][bj][m][1]); } }
    }
};
struct EpiF2 {
    static constexpr bool PERM = true, AFTER_DRAIN = false;
    bf16_t* mix; int S; const float* nyq;
    __device__ __forceinline__ void operator()(const f32x4 (&acc)[2][2][4][2], const Unit& u, int wr, int wc, int fr, int fq) const {
        const int row0 = u.pm * BM + wr * 64 + fr, col0 = u.pn * BM + wc * 32 + 8 * fq;
        f32x4 ny[2][2];
#pragma unroll
        for (int bj = 0; bj < 2; ++bj)
#pragma unroll
            for (int n = 0; n < 2; ++n) ny[bj][n] = *(const f32x4*)(nyq + col0 + bj * HALF + 4 * n);
#pragma unroll
        for (int ai = 0; ai < 2; ++ai)
#pragma unroll
            for (int m = 0; m < 4; ++m) { const int r = row0 + ai * HALF + m * 16; const float sg = (r & 1) ? -1.0f : 1.0f;
#pragma unroll
                for (int bj = 0; bj < 2; ++bj) { const int c = col0 + bj * HALF, z = c >> 9, cp = c & 511, b = z >> 2, g = z & 3;
                    const u32x4 w = pack8(acc[ai][bj][m][0] + ny[bj][0] * sg, acc[ai][bj][m][1] + ny[bj][1] * sg);
                    *(u32x4*)(mix + ((size_t)b * S + r) * 4096 + g * 512 + cp) = w;
                    if (r != 0) { bf16_t* mr = mix + ((size_t)b * S + (S - r)) * 4096 + g * 512;
                        const int A = (504 - cp) & 511;
                        typedef unsigned u32x2 __attribute__((ext_vector_type(2)));
                        mr[A + 1] = (bf16_t)(w.w >> 16);
                        *(unsigned*)(mr + A + 2) = (w.w & 0xffffu) | (w.z & 0xffff0000u);
                        *(u32x2*)(mr + A + 4) = (u32x2){(w.z & 0xffffu) | (w.y & 0xffff0000u), (w.y & 0xffffu) | (w.x & 0xffff0000u)};
                        mr[(A + 8) & 511] = (bf16_t)(w.x & 0xffffu); } } }
    }
};
__device__ __forceinline__ void row_stats(const float* st, int row, float& mu, float& rstd) { const float s = st[2 * row], ss = st[2 * row + 1]; mu = s * (1.0f / 4096.0f); rstd = rsqrtf(fmaxf(ss * (1.0f / 4096.0f) - mu * mu, 0.f) + 1e-5f); }
template <bool LN_IN> struct EpiResid {
    static constexpr bool PERM = true, AFTER_DRAIN = false;
    const float* x0; const float* x1p; float* outf; const bf16_t* xres; bf16_t* xb; const float* st_in; const float* g_in; const float* b_in; float* st_out; float alpha;
    __device__ __forceinline__ void operator()(const f32x4 (&acc)[2][2][4][2], const Unit& u, int wr, int wc, int fr, int fq) const {
        const int row0 = u.pm * BM + wr * 64 + fr, col0 = u.pn * BM + wc * 32 + 8 * fq;
        const float* xin = (u.pm < 64) ? x0 : x1p;
        f32x4 gv[2][2], bv[2][2];
        if (LN_IN) {
#pragma unroll
            for (int bj = 0; bj < 2; ++bj)
#pragma unroll
                for (int n = 0; n < 2; ++n) { gv[bj][n] = *(const f32x4*)(g_in + col0 + bj * HALF + 4 * n); bv[bj][n] = *(const f32x4*)(b_in + col0 + bj * HALF + 4 * n); } }
#pragma unroll
        for (int ai = 0; ai < 2; ++ai)
#pragma unroll
            for (int mp = 0; mp < 2; ++mp) {
                f32x4 xv[2][2][2]; float mu[2] = {0.f, 0.f}, rstd[2] = {1.f, 1.f};
                u32x4 wraw[2][2]; ::f32x2 sraw[2];
#pragma unroll
                for (int mm = 0; mm < 2; ++mm) { const int row = row0 + ai * HALF + (2 * mp + mm) * 16; const size_t off = (size_t)row * 4096 + col0;
#pragma unroll
                    for (int bj = 0; bj < 2; ++bj) {
                        if (LN_IN) wraw[mm][bj] = *(const u32x4*)(xres + off + bj * HALF);
                        else { xv[mm][bj][0] = *(const f32x4*)(xin + off + bj * HALF); xv[mm][bj][1] = *(const f32x4*)(xin + off + bj * HALF + 4); } }
                    if (LN_IN) sraw[mm] = *(const ::f32x2*)(st_in + 2 * row); }
                asm volatile("" ::: "memory");
                if (LN_IN) {
#pragma unroll
                    for (int mm = 0; mm < 2; ++mm) {
#pragma unroll
                        for (int bj = 0; bj < 2; ++bj) { const u32x4 w = wraw[mm][bj];
                            xv[mm][bj][0] = (f32x4){__builtin_bit_cast(float, w.x << 16), __builtin_bit_cast(float, w.x & 0xffff0000u), __builtin_bit_cast(float, w.y << 16), __builtin_bit_cast(float, w.y & 0xffff0000u)};
                            xv[mm][bj][1] = (f32x4){__builtin_bit_cast(float, w.z << 16), __builtin_bit_cast(float, w.z & 0xffff0000u), __builtin_bit_cast(float, w.w << 16), __builtin_bit_cast(float, w.w & 0xffff0000u)}; }
                        const float m_ = sraw[mm].x * (1.0f / 4096.0f); mu[mm] = m_; rstd[mm] = rsqrtf(fmaxf(sraw[mm].y * (1.0f / 4096.0f) - m_ * m_, 0.f) + 1e-5f); } }
#pragma unroll
                for (int mm = 0; mm < 2; ++mm) { const int m = 2 * mp + mm, row = row0 + ai * HALF + m * 16; const size_t off = (size_t)row * 4096 + col0;
                    float rs = 0.f, rss = 0.f;
#pragma unroll
                    for (int bj = 0; bj < 2; ++bj) { f32x4 v[2];
#pragma unroll
                        for (int n = 0; n < 2; ++n) { f32x4 x = xv[mm][bj][n];
                            if (LN_IN) x = (x - mu[mm]) * rstd[mm] * gv[bj][n] + bv[bj][n];
                            v[n] = x * alpha + acc[ai][bj][m][n];
                            rs += (v[n][0] + v[n][1]) + (v[n][2] + v[n][3]); rss += (v[n][0] * v[n][0] + v[n][1] * v[n][1]) + (v[n][2] * v[n][2] + v[n][3] * v[n][3]); }
                        if (outf) { *(f32x4*)(outf + off + bj * HALF) = v[0]; *(f32x4*)(outf + off + bj * HALF + 4) = v[1]; }
                        if (xb) *(u32x4*)(xb + off + bj * HALF) = pack8(v[0], v[1]); }
                    if (st_out) { rs += __shfl_xor(rs, 16); rss += __shfl_xor(rss, 16); rs += __shfl_xor(rs, 32); rss += __shfl_xor(rss, 32);
                        if (fq == 0) { atomicAdd(st_out + 2 * row, rs); atomicAdd(st_out + 2 * row + 1, rss); } } }
            }
    }
};
struct EpiStoreBfFold {
    static constexpr bool PERM = true, AFTER_DRAIN = false;
    bf16_t* O; int ldc; const float* st; const float* cs; const float* bw;
    __device__ __forceinline__ void operator()(const f32x4 (&acc)[2][2][4][2], const Unit& u, int wr, int wc, int fr, int fq) const {
        const int row0 = u.pm * BM + wr * 64 + fr, col0 = u.pn * BM + wc * 32 + 8 * fq;
        f32x4 c4[2][2], b4[2][2];
#pragma unroll
        for (int bj = 0; bj < 2; ++bj)
#pragma unroll
            for (int n = 0; n < 2; ++n) { c4[bj][n] = *(const f32x4*)(cs + col0 + bj * HALF + 4 * n); b4[bj][n] = *(const f32x4*)(bw + col0 + bj * HALF + 4 * n); }
        float mus[2][4], rsd[2][4];
        { ::f32x2 raw[2][4];
#pragma unroll
        for (int ai = 0; ai < 2; ++ai)
#pragma unroll
            for (int m = 0; m < 4; ++m) raw[ai][m] = *(const ::f32x2*)(st + 2 * (row0 + ai * HALF + m * 16));
        asm volatile("" ::: "memory");
#pragma unroll
        for (int ai = 0; ai < 2; ++ai)
#pragma unroll
            for (int m = 0; m < 4; ++m) { const float mu = raw[ai][m].x * (1.0f / 4096.0f); mus[ai][m] = mu; rsd[ai][m] = rsqrtf(fmaxf(raw[ai][m].y * (1.0f / 4096.0f) - mu * mu, 0.f) + 1e-5f); } }
#pragma unroll
        for (int ai = 0; ai < 2; ++ai)
#pragma unroll
            for (int m = 0; m < 4; ++m) { const int row = row0 + ai * HALF + m * 16; const float mu = mus[ai][m], rstd = rsd[ai][m];
                bf16_t* rowp = O + (size_t)row * ldc + col0;
#pragma unroll
                for (int bj = 0; bj < 2; ++bj) { const f32x4 y0 = (acc[ai][bj][m][0] - c4[bj][0] * mu) * rstd + b4[bj][0], y1 = (acc[ai][bj][m][1] - c4[bj][1] * mu) * rstd + b4[bj][1];
                    *(u32x4*)(rowp + bj * HALF) = pack8(y0, y1); } }
    }
};
struct EpiSwiGLU {
    static constexpr bool PERM = true, AFTER_DRAIN = false;
    bf16_t* H; int ldh; const float* st; const float* cs; const float* bw;
    __device__ __forceinline__ void operator()(const f32x4 (&acc)[2][2][4][2], const Unit& u, int wr, int wc, int fr, int fq) const {
        const int row0 = u.pm * BM + wr * 64 + fr, col0 = u.pn * HALF + wc * 32 + 8 * fq, cb = u.pn * BM + wc * 32 + 8 * fq;
        f32x4 c4[2][2], b4[2][2];
#pragma unroll
        for (int bj = 0; bj < 2; ++bj)
#pragma unroll
            for (int n = 0; n < 2; ++n) { c4[bj][n] = *(const f32x4*)(cs + cb + bj * HALF + 4 * n); b4[bj][n] = *(const f32x4*)(bw + cb + bj * HALF + 4 * n); }
        float mus[2][4], rsd[2][4];
        { ::f32x2 raw[2][4];
#pragma unroll
        for (int ai = 0; ai < 2; ++ai)
#pragma unroll
            for (int m = 0; m < 4; ++m) raw[ai][m] = *(const ::f32x2*)(st + 2 * (row0 + ai * HALF + m * 16));
        asm volatile("" ::: "memory");
#pragma unroll
        for (int ai = 0; ai < 2; ++ai)
#pragma unroll
            for (int m = 0; m < 4; ++m) { const float mu = raw[ai][m].x * (1.0f / 4096.0f); mus[ai][m] = mu; rsd[ai][m] = rsqrtf(fmaxf(raw[ai][m].y * (1.0f / 4096.0f) - mu * mu, 0.f) + 1e-5f); } }
#pragma unroll
        for (int ai = 0; ai < 2; ++ai)
#pragma unroll
            for (int m = 0; m < 4; ++m) { const int row = row0 + ai * HALF + m * 16; const float mu = mus[ai][m], rstd = rsd[ai][m];
                f32x4 h[2];
                f32x4 a1[2], a3[2], e[2];
#pragma unroll
                for (int n = 0; n < 2; ++n) { a1[n] = (acc[ai][0][m][n] - c4[0][n] * mu) * rstd + b4[0][n]; a3[n] = (acc[ai][1][m][n] - c4[1][n] * mu) * rstd + b4[1][n]; e[n] = a1[n] * -1.4426950408889634f; }
#pragma unroll
                for (int n = 0; n < 2; ++n)
#pragma unroll
                    for (int j = 0; j < 4; ++j) e[n][j] = __builtin_amdgcn_exp2f(e[n][j]);
                asm volatile("" : "+v"(e[0]), "+v"(e[1]));
                e[0] = e[0] + 1.0f; e[1] = e[1] + 1.0f;
#pragma unroll
                for (int n = 0; n < 2; ++n)
#pragma unroll
                    for (int j = 0; j < 4; ++j) e[n][j] = __builtin_amdgcn_rcpf(e[n][j]);
                asm volatile("" : "+v"(e[0]), "+v"(e[1]));
                h[0] = a1[0] * a3[0] * e[0]; h[1] = a1[1] * a3[1] * e[1];
                *(u32x4*)(H + (size_t)row * ldh + col0) = pack8(h[0], h[1]); }
    }
};
template <class Epi, class Sched, bool ALIGN_EPI = false, bool SP2 = false>
__device__ __forceinline__ void gemm_phase(PG8_LAS unsigned char* lds, const Gemm g, const Sched& S, const Epi& E) {
    int tid_ = threadIdx.x; asm volatile("" : "+v"(tid_));
    const int tid = tid_, wid = __builtin_amdgcn_readfirstlane(tid >> 6), lane = tid & 63, wr = wid >> 2, wc = wid & 3, fr = lane & 15, fq = lane >> 4;
    const int K = g.K, nt = K / BK;
    unsigned voffA[2], voffB[2];
#pragma unroll
    for (int i = 0; i < 2; ++i) { int R, C; stage_rc(tid * 16 + i * 8192, R, C); const int Rb = Epi::PERM ? ((R & ~31) + perm32(R & 31)) : R;
        voffA[i] = (unsigned)(R * K + C) * 2u; voffB[i] = (unsigned)(Rb * K + C) * 2u; }
    const size_t kstep = (size_t)(BK * 2);
    const size_t hstep = (size_t)HALF * K * 2;
    const size_t tstep = 2 * hstep;
    const unsigned ldsw = (unsigned)wid * 1024u;
    const int aoff = lds_byte(wr * 64 + fr, fq * 8), boff = lds_byte(wc * 32 + fr, fq * 8);
#define PG8_SA(b, h) (((b) * 2 + (h)) * HTB)
#define PG8_SB(b, h) ((4 + (b) * 2 + (h)) * HTB)
#define PG8_STAGE(bufoff, gbase, voff) do { _Pragma("unroll") for (int _i = 0; _i < 2; ++_i) \
        __builtin_amdgcn_global_load_lds((const unsigned*)((const char*)(gbase) + (voff)[_i]), (PG8_LAS unsigned*)(lds + (bufoff) + ldsw + _i * 8192), 16, 0, 0); } while (0)
#define PG8_LDA(dst, b, h) do { _Pragma("unroll") for (int m = 0; m < 4; ++m) _Pragma("unroll") for (int k = 0; k < 2; ++k) dst[m][k] = *(const PG8_LAS bf16x8*)(lds + PG8_SA(b, h) + aoff + m * 2048 + k * 1024); } while (0)
#define PG8_LDB(dst, b, h) do { _Pragma("unroll") for (int n = 0; n < 2; ++n) _Pragma("unroll") for (int k = 0; k < 2; ++k) dst[n][k] = *(const PG8_LAS bf16x8*)(lds + PG8_SB(b, h) + boff + n * 2048 + k * 1024); } while (0)
#define PG8_MMA(ai, bj, At, Bt) do { __builtin_amdgcn_s_setprio(1); _Pragma("unroll") for (int m = 0; m < 4; ++m) _Pragma("unroll") for (int n = 0; n < 2; ++n) _Pragma("unroll") for (int k = 0; k < 2; ++k) \
        acc[ai][bj][m][n] = __builtin_amdgcn_mfma_f32_16x16x32_bf16(Bt[n][k], At[m][k], acc[ai][bj][m][n], 0, 0, 0); __builtin_amdgcn_s_setprio(0); } while (0)
#define PG8_WAIT_V(n) asm volatile("s_waitcnt vmcnt(" #n ")" ::: "memory")
#define PG8_WAIT_L(n) asm volatile("s_waitcnt lgkmcnt(" #n ")" ::: "memory")
#define PG8_BAR __builtin_amdgcn_s_barrier()
#define PG8_SCHED __builtin_amdgcn_sched_barrier(0)
    Unit cur, nxt; int ui = 0;
    if (!S.next(0, cur)) return;
    f32x4 acc[2][2][4][2];
#pragma unroll
    for (int a = 0; a < 2; ++a)
#pragma unroll
        for (int b = 0; b < 2; ++b)
#pragma unroll
            for (int m = 0; m < 4; ++m)
#pragma unroll
                for (int n = 0; n < 2; ++n) acc[a][b][m][n] = (f32x4){0.f, 0.f, 0.f, 0.f};
    bf16x8 At[4][2], B0[2][2], B1[2][2];
    const char* cA = (const char*)g.A + (size_t)cur.pm * tstep; const char* cB = (const char*)g.Bt + (size_t)cur.pn * tstep;
    S.a_ready(cur);
    if constexpr (SP2) {
        PG8_STAGE(PG8_SB(0, 0), cB, voffB); PG8_STAGE(PG8_SB(0, 1), cB + hstep, voffB); PG8_STAGE(PG8_SA(0, 0), cA, voffA); PG8_STAGE(PG8_SA(0, 1), cA + hstep, voffA);
        if (wr == 1) PG8_BAR;
        PG8_WAIT_V(2); PG8_BAR;
        PG8_STAGE(PG8_SB(1, 0), cB + kstep, voffB); PG8_STAGE(PG8_SA(1, 0), cA + kstep, voffA); PG8_STAGE(PG8_SB(1, 1), cB + hstep + kstep, voffB);
        PG8_WAIT_V(6); PG8_BAR;
    } else {
        PG8_STAGE(PG8_SB(0, 0), cB, voffB); PG8_STAGE(PG8_SA(0, 0), cA, voffA); PG8_STAGE(PG8_SB(0, 1), cB + hstep, voffB); PG8_STAGE(PG8_SA(0, 1), cA + hstep, voffA);
        if (wr == 1) PG8_BAR;
        PG8_WAIT_V(4); PG8_BAR;
        PG8_STAGE(PG8_SB(1, 0), cB + kstep, voffB); PG8_STAGE(PG8_SA(1, 0), cA + kstep, voffA); PG8_STAGE(PG8_SB(1, 1), cB + hstep + kstep, voffB);
        PG8_WAIT_V(6); PG8_BAR;
    }
    for (;;) {
        const bool has_next = S.next(ui + 1, nxt);
        const char* nA = has_next ? (const char*)g.A + (size_t)nxt.pm * tstep : cA; const char* nB = has_next ? (const char*)g.Bt + (size_t)nxt.pn * tstep : cB;
        for (int t = 0; t < nt; t += 2) {
            const bool last = (t == nt - 2);
            const char* a1 = cA + (size_t)(t + 1) * kstep;
            const char* a2 = last ? nA : cA + (size_t)(t + 2) * kstep; const char* b2 = last ? nB : cB + (size_t)(t + 2) * kstep;
            const char* a3 = a2 + kstep; const char* b3 = b2 + kstep;
            if (last && has_next) S.a_ready(nxt);
            if constexpr (SP2) {
            PG8_LDB(B0, 0, 0); PG8_LDB(B1, 0, 1); PG8_SCHED; PG8_LDA(At, 0, 0); PG8_STAGE(PG8_SA(1, 1), a1 + hstep, voffA);
            PG8_WAIT_V(8); PG8_WAIT_L(0); PG8_BAR; PG8_MMA(0, 0, At, B0); PG8_MMA(0, 1, At, B1); PG8_BAR; PG8_SCHED;
            PG8_LDA(At, 0, 1); PG8_STAGE(PG8_SB(0, 0), b2, voffB); PG8_STAGE(PG8_SB(0, 1), b2 + hstep, voffB); PG8_STAGE(PG8_SA(0, 0), a2, voffA);
            PG8_WAIT_V(8); PG8_WAIT_L(0); PG8_BAR; PG8_MMA(1, 0, At, B0); PG8_MMA(1, 1, At, B1); PG8_BAR; PG8_SCHED;
            PG8_LDB(B0, 1, 0); PG8_LDB(B1, 1, 1); PG8_SCHED; PG8_LDA(At, 1, 0); PG8_STAGE(PG8_SA(0, 1), a2 + hstep, voffA);
            PG8_WAIT_V(8); PG8_WAIT_L(0); PG8_BAR; PG8_MMA(0, 0, At, B0); PG8_MMA(0, 1, At, B1); PG8_BAR; PG8_SCHED;
            PG8_LDA(At, 1, 1); PG8_STAGE(PG8_SB(1, 0), b3, voffB); PG8_STAGE(PG8_SB(1, 1), b3 + hstep, voffB); PG8_STAGE(PG8_SA(1, 0), a3, voffA);
            PG8_WAIT_V(8); PG8_WAIT_L(0); PG8_BAR; PG8_MMA(1, 0, At, B0); PG8_MMA(1, 1, At, B1); PG8_BAR; PG8_SCHED;
            } else {
            PG8_LDB(B0, 0, 0); PG8_SCHED; PG8_LDA(At, 0, 0); PG8_STAGE(PG8_SA(1, 1), a1 + hstep, voffA);
            PG8_WAIT_L(8); PG8_BAR; PG8_WAIT_L(0); PG8_MMA(0, 0, At, B0); PG8_BAR; PG8_SCHED;
            PG8_LDB(B1, 0, 1); PG8_STAGE(PG8_SB(0, 0), b2, voffB);
            PG8_BAR; PG8_WAIT_L(0); PG8_MMA(0, 1, At, B1); PG8_BAR;
            PG8_LDA(At, 0, 1); PG8_STAGE(PG8_SA(0, 0), a2, voffA);
            PG8_BAR; PG8_WAIT_L(0); PG8_MMA(1, 0, At, B0); PG8_BAR; PG8_SCHED;
            PG8_STAGE(PG8_SB(0, 1), b2 + hstep, voffB);
            PG8_WAIT_V(6); PG8_BAR; PG8_MMA(1, 1, At, B1); PG8_BAR;
            PG8_LDB(B0, 1, 0); PG8_SCHED; PG8_LDA(At, 1, 0); PG8_STAGE(PG8_SA(0, 1), a2 + hstep, voffA);
            PG8_WAIT_L(8); PG8_BAR; PG8_WAIT_L(0); PG8_MMA(0, 0, At, B0); PG8_BAR; PG8_SCHED;
            PG8_LDB(B1, 1, 1); PG8_STAGE(PG8_SB(1, 0), b3, voffB);
            PG8_BAR; PG8_WAIT_L(0); PG8_MMA(0, 1, At, B1); PG8_BAR;
            PG8_LDA(At, 1, 1); PG8_STAGE(PG8_SA(1, 0), a3, voffA);
            PG8_BAR; PG8_WAIT_L(0); PG8_MMA(1, 0, At, B0); PG8_BAR; PG8_SCHED;
            PG8_STAGE(PG8_SB(1, 1), b3 + hstep, voffB);
            PG8_WAIT_V(6); PG8_BAR; PG8_MMA(1, 1, At, B1); PG8_BAR;
            }
        }
        if constexpr (ALIGN_EPI) { if (wr == 0) PG8_BAR; }
        if constexpr (!Epi::AFTER_DRAIN) { E(acc, cur, wr, wc, fr, fq); S.done(cur); }
        if (!has_next) break;
#pragma unroll
        for (int a = 0; a < 2; ++a)
#pragma unroll
            for (int b = 0; b < 2; ++b)
#pragma unroll
                for (int m = 0; m < 4; ++m)
#pragma unroll
                    for (int n = 0; n < 2; ++n) acc[a][b][m][n] = (f32x4){0.f, 0.f, 0.f, 0.f};
        cur = nxt; cA = nA; cB = nB; ++ui;
        if constexpr (ALIGN_EPI) { if (wr == 1) PG8_BAR; }
    }
    PG8_WAIT_V(0);
    if constexpr (!ALIGN_EPI) { if (wr == 0) PG8_BAR; }
    PG8_BAR;
    if constexpr (Epi::AFTER_DRAIN) { E.fused(acc, cur, wr, wc, fr, fq, lds, wid, lane); S.done(cur); }
#undef PG8_SA
#undef PG8_SB
#undef PG8_STAGE
#undef PG8_LDA
#undef PG8_LDB
#undef PG8_MMA
#undef PG8_WAIT_V
#undef PG8_WAIT_L
#undef PG8_BAR
#undef PG8_SCHED
}
}
#define XB_TMO      128
#define XB_XCNT(j)  (256  + 64 * (j))
#define XB_XSUB(j)  (1280 + 64 * (j))
#define XB_XGEN(j)  (2304 + 64 * (j))
#define XB_TOP      3328
#define XB_TOPGEN   3392
#define XCD_BAR_WORDS 3456
#define XB_SPIN_CAP (1u << 18)

__device__ __forceinline__ unsigned xb_ld(unsigned* p)              { return __hip_atomic_load(p, __ATOMIC_RELAXED, __HIP_MEMORY_SCOPE_AGENT); }
__device__ __forceinline__ unsigned xb_add(unsigned* p, unsigned v) { return __hip_atomic_fetch_add(p, v, __ATOMIC_RELAXED, __HIP_MEMORY_SCOPE_AGENT); }
__device__ __forceinline__ unsigned xb_xcc_id() { return (unsigned)__builtin_amdgcn_s_getreg((3 << 11) | 20) & 0xFu; }
#define XB_SPIN(cond, bar) do { unsigned _sp = 0; while (cond) { __builtin_amdgcn_s_sleep(1); \
    if ((++_sp & 255u) == 0u) { if (xb_ld(&(bar)[XB_TMO])) break; if (_sp > XB_SPIN_CAP) { atomicAdd(&(bar)[XB_TMO], 1u); break; } } } } while (0)

struct XcdBarrier {
    unsigned* bar; unsigned x;
    volatile LAS unsigned* st;
};

__device__ __forceinline__ XcdBarrier xcd_barrier_post(unsigned* bar, volatile LAS unsigned* st) {
    XcdBarrier b; b.bar = bar; b.x = xb_xcc_id(); b.st = st;
    if (threadIdx.x == 0) (void)xb_add(&bar[XB_XCNT(b.x)], 1u);
    return b;
}
__device__ __forceinline__ void xcd_barrier_complete(unsigned* bar, unsigned x, unsigned& nloc, unsigned& nx) {
    const unsigned G = gridDim.x * gridDim.y * gridDim.z;
    unsigned sum, cnt, mine, sp = 0u;
    for (;;) {
        sum = 0u; cnt = 0u; mine = 0u;
#pragma unroll
        for (unsigned j = 0; j < 16; ++j) { const unsigned c = xb_ld(&bar[XB_XCNT(j)]); sum += c; cnt += (c > 0u) ? 1u : 0u; mine = (j == x) ? c : mine; }
        if (sum == G) break;
        __builtin_amdgcn_s_sleep(1);
        if ((++sp & 255u) == 0u) { if (xb_ld(&bar[XB_TMO])) break; if (sp > XB_SPIN_CAP) { atomicAdd(&bar[XB_TMO], 1u); break; } }
    }
    nloc = mine > 0u ? mine : 1u; nx = cnt > 0u ? cnt : 1u;
}

__device__ __forceinline__ void xcd_barrier(const XcdBarrier& b) {
    asm volatile("s_waitcnt vmcnt(0)" ::: "memory");
    __syncthreads();
    if (threadIdx.x == 0) {
        unsigned* bar = b.bar;
        __builtin_amdgcn_s_waitcnt(0);
        unsigned nloc = b.st[0], nx = b.st[1];
        if (nloc == 0u) { xcd_barrier_complete(bar, b.x, nloc, nx); b.st[0] = nloc; b.st[1] = nx; }
        const unsigned old = xb_add(&bar[XB_XSUB(b.x)], 1u);
        const unsigned gen = old / nloc;
        if (old + 1u == (gen + 1u) * nloc) {
            __builtin_amdgcn_fence(__ATOMIC_RELEASE, "agent");
            asm volatile("s_waitcnt vmcnt(0)" ::: "memory");
            const unsigned og = xb_add(&bar[XB_TOP], 1u);
            const unsigned tg = og / nx;
            if (og + 1u == (tg + 1u) * nx) xb_add(&bar[XB_TOPGEN], 1u);
            else XB_SPIN(xb_ld(&bar[XB_TOPGEN]) == tg, bar);
            __builtin_amdgcn_fence(__ATOMIC_ACQUIRE, "agent");
            xb_add(&bar[XB_XGEN(b.x)], 1u);
            asm volatile("s_waitcnt vmcnt(0)" ::: "memory");
        } else {
            XB_SPIN(xb_ld(&bar[XB_XGEN(b.x)]) == gen, bar);
            __builtin_amdgcn_fence(__ATOMIC_ACQUIRE, "agent");
            asm volatile("s_waitcnt vmcnt(0)" ::: "memory");
        }
    }
    __syncthreads();
}
#define OPAQUE(v) asm volatile("" : "+v"(v))
struct Frame {
    LAS unsigned char* lds;
    volatile LAS unsigned* MISC;
    unsigned* ctl;
    int tid, lane, wave, G;
    int gw, NGW;
};
__device__ __forceinline__ void frame_refresh(Frame& F) { int t = threadIdx.x; OPAQUE(t); F.tid = t; F.lane = t & 63; }

template <bool FOLD>
__device__ __forceinline__ void p0_process_item(int K, int N, bf16* WT, int G, int which, LAS float* scr, int item, int lane, f32x4 g0, f32x4 g1, f32x4 b0, f32x4 b1, float* cs, float* bw) {
    const int nblk = N / 32, kb = item / nblk, nb = item % nblk, k0 = 64 * kb, n0 = 32 * nb;
    const int c = lane & 7;
    float psA[4], pbA[4]; int rA[4];
#pragma unroll
    for (int j = 0; j < 4; ++j) { const int n = (lane >> 3) + 8 * j; const LAS float* s = scr + (8 * c) * 33 + n;
        float w8[8];
#pragma unroll
        for (int i = 0; i < 8; ++i) w8[i] = s[i * 33];
        float pb = 0.f;
        if (FOLD) {
#pragma unroll
            for (int i = 0; i < 8; ++i) { const float gg = (i < 4) ? g0[i & 3] : g1[i & 3], bb = (i < 4) ? b0[i & 3] : b1[i & 3]; pb += bb * w8[i]; w8[i] *= gg; } }
        v4u o; o.x = pk2(w8[0], w8[1]); o.y = pk2(w8[2], w8[3]); o.z = pk2(w8[4], w8[5]); o.w = pk2(w8[6], w8[7]);
        const int col = n0 + n; const int r = (G == 0) ? col : ((col / G) * 2 * G + which * G + col % G);
        *(GAS v4u*)(WT + (size_t)r * K + k0 + 8 * c) = o;
        if (FOLD) { float ps = 0.f;
#pragma unroll
            for (int i = 0; i < 4; ++i) ps += bf2f(o[i] & 0xffffu) + bf2f(o[i] >> 16);
            psA[j] = sum8(ps); pbA[j] = sum8(pb); rA[j] = r; } }
    if (FOLD) { const int jj = c & 3; const bool isb = (c & 4) != 0;
        const float vs = jj == 0 ? psA[0] : jj == 1 ? psA[1] : jj == 2 ? psA[2] : psA[3], vb = jj == 0 ? pbA[0] : jj == 1 ? pbA[1] : jj == 2 ? pbA[2] : pbA[3];
        const int rr = jj == 0 ? rA[0] : jj == 1 ? rA[1] : jj == 2 ? rA[2] : rA[3];
        atomicAdd((isb ? bw : cs) + rr, isb ? vb : vs); }
}
template <bool FOLD>
__device__ __forceinline__ void cvt_weight_impl(Frame& F, const float* W, int K, int N, bf16* WT, int G, int which, const float* gv, const float* bv, float* cs, float* bw) {
    frame_refresh(F);
    LAS float* scr = (LAS float*)(F.lds + RING_OFF + F.wave * 16384);
    const int nitems = (K / 64) * (N / 32), nblk = N / 32, lane = F.lane;
    float r[32];
    int it = F.gw;
    if (it >= nitems) return;
    { const int kb = it / nblk, nb = it % nblk; const float* src = W + (size_t)(64 * kb + (lane >> 5)) * N + 32 * nb + (lane & 31);
#pragma unroll
        for (int i = 0; i < 32; ++i) r[i] = __builtin_nontemporal_load(src + (size_t)(2 * i) * N);
#pragma unroll
        for (int i = 0; i < 32; ++i) scr[(2 * i + (lane >> 5)) * 33 + (lane & 31)] = r[i]; }
#pragma unroll 1
    for (; it < nitems; it += F.NGW) {
        const int nx = (it + F.NGW < nitems) ? it + F.NGW : it;
        f32x4 g0 = {0.f, 0.f, 0.f, 0.f}, g1 = g0, b0 = g0, b1 = g0;
        if (FOLD) { const int kq = 64 * (it / nblk) + 8 * (lane & 7); g0 = *(const f32x4*)(gv + kq); g1 = *(const f32x4*)(gv + kq + 4); b0 = *(const f32x4*)(bv + kq); b1 = *(const f32x4*)(bv + kq + 4); asm volatile("" ::: "memory"); }
        { const int kb = nx / nblk, nb = nx % nblk; const float* src = W + (size_t)(64 * kb + (lane >> 5)) * N + 32 * nb + (lane & 31);
#pragma unroll
            for (int i = 0; i < 32; ++i) r[i] = __builtin_nontemporal_load(src + (size_t)(2 * i) * N); }
        LDS_WAIT(); asm volatile("" ::: "memory");
        p0_process_item<FOLD>(K, N, WT, G, which, scr, it, lane, g0, g1, b0, b1, cs, bw);
        LDS_WAIT(); asm volatile("" ::: "memory");
#pragma unroll
        for (int i = 0; i < 32; ++i) scr[(2 * i + (lane >> 5)) * 33 + (lane & 31)] = r[i];
    }
}
__device__ __forceinline__ void cvt_weight(Frame& F, const float* W, int K, int N, bf16* WT, int G, int which) { cvt_weight_impl<false>(F, W, K, N, WT, G, which, nullptr, nullptr, nullptr, nullptr); }
__device__ __forceinline__ void cvt_weight_fold(Frame& F, const float* W, int K, int N, bf16* WT, int G, int which, const float* gv, const float* bv, float* cs, float* bw) { cvt_weight_impl<true>(F, W, K, N, WT, G, which, gv, bv, cs, bw); }
__device__ __forceinline__ void cvt_rows_bf16(Frame& F, const float* x, bf16* y, size_t n8) {
    frame_refresh(F);
    for (size_t i = (size_t)blockIdx.x * 512 + F.tid; i < n8; i += (size_t)F.G * 512) {
        const f32x4 a = __builtin_nontemporal_load((const f32x4*)(x + i * 8)), b = __builtin_nontemporal_load((const f32x4*)(x + i * 8 + 4));
        v4u o; o.x = pk2(a[0], a[1]); o.y = pk2(a[2], a[3]); o.z = pk2(b[0], b[1]); o.w = pk2(b[2], b[3]);
        *(v4u*)(y + i * 8) = o;
    }
}
__device__ __forceinline__ void gen_dftc(Frame& F, bf16* Dc) {
    frame_refresh(F);
    for (int i = blockIdx.x * 512 + F.tid; i < 1024 * 512; i += F.G * 512) {
        const int r = i >> 9, c = i & 511, rr = r & 511; const int idx = (rr * c) & 511;
        float s, co; sincospif(2.0f * (float)idx / 512.0f, &s, &co);
        Dc[i] = (bf16)f2bf((r < 512 ? co : s) * 0.04419417382415922f);
    }
}
__device__ __forceinline__ void gen_dfts(Frame& F, bf16* Ds, int lgS) {
    frame_refresh(F);
    const int S = 1 << lgS, H = S >> 1; const float sc = 1.0f / sqrtf((float)S);
    for (size_t i = (size_t)blockIdx.x * 512 + F.tid; i < ((size_t)1 << (2 * lgS - 1)); i += (size_t)F.G * 512) {
        const int sp = (int)(i >> lgS), k = (int)(i & (size_t)(S - 1)), r = k & (H - 1); const int idx = (int)(((long)sp * r) & (S - 1));
        float sn, co; sincospif(2.0f * (float)idx / (float)S, &sn, &co);
        Ds[i] = (bf16)f2bf(k < H ? co * sc : (k == H ? 0.f : -sn * sc));
    }
}

__device__ __forceinline__ void headnorm_phase(Frame& F, const bf16* O, const bf16* proj, const float* hg, bf16* mix) {
    frame_refresh(F);
    const int h = F.gw & 3, lane = F.lane;
    int t = F.gw;
    if (t >= MH * 4) return;
    const f32x4 g0 = *(const f32x4*)(hg + h * 512 + lane * 8), g1 = *(const f32x4*)(hg + h * 512 + lane * 8 + 4);
    v4u nof, nob, nrr;
    { const int row = t >> 2; nof = *(const v4u*)(O + (size_t)row * 2048 + h * 512 + lane * 8); nob = *(const v4u*)(O + (size_t)MH * 2048 + (size_t)row * 2048 + h * 512 + lane * 8);
      nrr = *(const v4u*)(proj + (size_t)row * 8192 + 6144 + h * 512 + lane * 8); }
#pragma unroll 1
    for (; t < MH * 4; t += F.NGW) { const int row = t >> 2;
        const v4u of = nof, ob = nob, rr = nrr;
        { const int rn = ((t + F.NGW < MH * 4) ? t + F.NGW : t) >> 2;
          nof = *(const v4u*)(O + (size_t)rn * 2048 + h * 512 + lane * 8); nob = *(const v4u*)(O + (size_t)MH * 2048 + (size_t)rn * 2048 + h * 512 + lane * 8);
          nrr = *(const v4u*)(proj + (size_t)rn * 8192 + 6144 + h * 512 + lane * 8); }
        float v[8];
#pragma unroll
        for (int j = 0; j < 4; ++j) { v[2 * j] = bf2f(of[j] & 0xffffu) + bf2f(ob[j] & 0xffffu); v[2 * j + 1] = bf2f(of[j] >> 16) + bf2f(ob[j] >> 16); }
        float s = 0.f;
#pragma unroll
        for (int j = 0; j < 8; ++j) s += v[j];
        const float mean = wave_sum(s) * (1.0f / 512.0f); float q = 0.f;
#pragma unroll
        for (int j = 0; j < 8; ++j) { v[j] -= mean; q += v[j] * v[j]; }
        const float rstd = rsqrtf(wave_sum(q) * (1.0f / 512.0f) + LN_EPS);
        float o[8];
#pragma unroll
        for (int j = 0; j < 8; ++j) { const float r = bf2f((j & 1) ? (rr[j >> 1] >> 16) : (rr[j >> 1] & 0xffffu)); const float gv = (j < 4) ? g0[j & 3] : g1[j & 3]; o[j] = v[j] * rstd * gv * silu_f(r); }
        v4u w; w.x = pk2(o[0], o[1]); w.y = pk2(o[2], o[3]); w.z = pk2(o[4], o[5]); w.w = pk2(o[6], o[7]);
        *(v4u*)(mix + (size_t)row * D + 2048 + h * 512 + lane * 8) = w; }
}
__device__ __forceinline__ void f2_mid_row(Frame& F, const bf16* B2, const float* nyq, bf16* mix, int S, int nz) {
    frame_refresh(F);
    const float isq = rsqrtf((float)S);
    for (int t = F.gw; t < nz * 512; t += F.NGW) { const int z = t >> 9, cp = t & 511, b = z >> 2, g = z & 3;
        const bf16* rp = B2 + (size_t)t * S; float acc = 0.f;
        for (int k0 = F.lane * 8; k0 < (S >> 1); k0 += 512) { const v4u w = *(const v4u*)(rp + k0);
            acc += (bf2f(w.x & 0xffffu) - bf2f(w.x >> 16)) + (bf2f(w.y & 0xffffu) - bf2f(w.y >> 16)) + (bf2f(w.z & 0xffffu) - bf2f(w.z >> 16)) + (bf2f(w.w & 0xffffu) - bf2f(w.w >> 16)); }
        acc = wave_sum(acc);
        if (F.lane == 0) mix[((size_t)b * S + (S >> 1)) * D + g * 512 + cp] = (bf16)f2bf(acc * isq + nyq[t]); }
}
__device__ __forceinline__ void ln_phase(Frame& F, const float* xin, float* x, const float* g, const float* bta, bf16* xb) {
    frame_refresh(F);
    for (int row = F.gw; row < M; row += F.NGW) { const int lane = F.lane;
        float* xr = x + (size_t)row * D; const float* xi = xin + (size_t)row * D;
        f32x4 v[16]; float s = 0.f;
#pragma unroll
        for (int j = 0; j < 16; ++j) { v[j] = __builtin_nontemporal_load((const f32x4*)(xi + j * 256 + lane * 4)); s += (v[j][0] + v[j][1]) + (v[j][2] + v[j][3]); }
        const float mean = wave_sum(s) * (1.0f / D); float q = 0.f;
#pragma unroll
        for (int j = 0; j < 16; ++j) { v[j] = v[j] - mean; q += (v[j][0] * v[j][0] + v[j][1] * v[j][1]) + (v[j][2] * v[j][2] + v[j][3] * v[j][3]); }
        const float rstd = rsqrtf(wave_sum(q) * (1.0f / D) + LN_EPS);
#pragma unroll
        for (int j = 0; j < 16; ++j) { const int c = j * 256 + lane * 4; const f32x4 gg = *(const f32x4*)(g + c), bb = *(const f32x4*)(bta + c);
            const f32x4 o = v[j] * rstd * gg + bb; __builtin_nontemporal_store(o, (f32x4*)(xr + c));
            if (xb) { v2u w; w.x = pk2(o[0], o[1]); w.y = pk2(o[2], o[3]); *(v2u*)(xb + (size_t)row * D + c) = w; } } }
}
__device__ __forceinline__ int t5_bucket(int rel) {
    const int n = rel < 0 ? -rel : rel; int b;
    if (n < 8) b = n; else if (n < 12) b = 8; else if (n < 16) b = 9; else if (n < 23) b = 10; else if (n < 32) b = 11; else if (n < 46) b = 12; else if (n < 64) b = 13; else if (n < 91) b = 14; else b = 15;
    return b + (rel > 0 ? 16 : 0);
}
typedef float f32x16 __attribute__((ext_vector_type(16)));
#define MFMA32(a, b, c) __builtin_amdgcn_mfma_f32_32x32x16_bf16((a), (b), (c), 0, 0, 0)
__device__ __forceinline__ int crow(int r, int hh) { return (r & 3) + 8 * (r >> 2) + 4 * hh; }
__device__ __forceinline__ void p2_phase(Frame& F, const bf16* xbh, const bf16* Wg, const float* w2, const float* gb, const bf16* proj, const float* fg, bf16* un,
                                         bf16* QK, bf16* KT, bf16* PB, float* EB, const bf16* Dc, float* nyq, int S) {
    frame_refresh(F);
    LAS float* lrp = (LAS float*)(F.lds + RING_OFF);
    for (int cu = blockIdx.x; cu < MH / 64; cu += F.G) {
        const int row0 = cu * 64;
        { const int rt = F.wave & 3, kh = F.wave >> 2, fr = F.lane & 15, fq = F.lane >> 4;
          const bf16* ap = xbh + (size_t)(row0 + rt * 16 + fr) * D + kh * 2048 + 8 * fq;
          const bf16* bp0 = Wg + (size_t)fr * D + kh * 2048 + 8 * fq; const bf16* bp1 = bp0 + (size_t)16 * D;
          f32x4 a0 = (f32x4){0.f, 0.f, 0.f, 0.f}, a1 = a0;
#pragma unroll 1
          for (int k8 = 0; k8 < 8; ++k8) { bf16x8 av[8], b0[8], b1[8];
#pragma unroll
              for (int ks = 0; ks < 8; ++ks) { av[ks] = *(const bf16x8*)(ap + (k8 * 8 + ks) * 32); b0[ks] = *(const bf16x8*)(bp0 + (k8 * 8 + ks) * 32); b1[ks] = *(const bf16x8*)(bp1 + (k8 * 8 + ks) * 32); }
#pragma unroll
              for (int ks = 0; ks < 8; ++ks) { a0 = __builtin_amdgcn_mfma_f32_16x16x32_bf16(av[ks], b0[ks], a0, 0, 0, 0); a1 = __builtin_amdgcn_mfma_f32_16x16x32_bf16(av[ks], b1[ks], a1, 0, 0, 0); } }
#pragma unroll
          for (int j = 0; j < 4; ++j) { lrp[kh * 2048 + (rt * 16 + 4 * fq + j) * 32 + fr] = a0[j]; lrp[kh * 2048 + (rt * 16 + 4 * fq + j) * 32 + 16 + fr] = a1[j]; } }
        __syncthreads();
        for (int i = F.tid; i < 2048; i += 512) lrp[i] += lrp[2048 + i];
        __syncthreads();
        { const int ch = 2 * F.tid;
#pragma unroll 1
          for (int dir = 0; dir < 2; ++dir) {
              f32x2 w[16];
#pragma unroll
              for (int r = 0; r < 16; ++r) w[r] = *(const f32x2*)(w2 + (dir * 16 + r) * 1024 + ch);
              const f32x2 bb = *(const f32x2*)(gb + dir * 1024 + ch);
              bf16* Qd = QK + (size_t)dir * 2 * MH * 1024; bf16* Kd = Qd + (size_t)MH * 1024;
              bf16* KTc = KT + (((size_t)dir * (MH / 64) + cu) * 1024 + ch) * 64;
              f32x2 g = (f32x2){0.f, 0.f};
              unsigned qn8[8], kn8[8];
#pragma unroll
              for (int ii = 0; ii < 8; ++ii) { const int row = dir ? 63 - ii : ii;
                  qn8[ii] = *(const unsigned*)(proj + (size_t)(row0 + row) * 8192 + 2048 + ch); kn8[ii] = *(const unsigned*)(proj + (size_t)(row0 + row) * 8192 + 3072 + ch); }
              auto gate_group = [&](const int i8) {
                  unsigned kt0[8], kt1[8], qv8[8], kv8[8];
#pragma unroll
                  for (int ii = 0; ii < 8; ++ii) { qv8[ii] = qn8[ii]; kv8[ii] = kn8[ii]; }
                  { const int gn = i8 < 7 ? i8 + 1 : 7;
#pragma unroll
                      for (int ii = 0; ii < 8; ++ii) { const int rs = gn * 8 + ii, row = dir ? 63 - rs : rs;
                          qn8[ii] = *(const unsigned*)(proj + (size_t)(row0 + row) * 8192 + 2048 + ch); kn8[ii] = *(const unsigned*)(proj + (size_t)(row0 + row) * 8192 + 3072 + ch); } }
#pragma unroll
                  for (int ii = 0; ii < 8; ++ii) {
                      const int rs = i8 * 8 + ii, row = dir ? 63 - rs : rs;
                      f32x2 z = bb;
#pragma unroll
                      for (int r = 0; r < 16; ++r) { const float l = lrp[row * 32 + dir * 16 + r]; z += w[r] * l; }
                      g.x += (fminf(z.x, 0.f) - 0.6931471805599453f * __builtin_amdgcn_logf(1.0f + __builtin_amdgcn_exp2f(-1.4426950408889634f * fabsf(z.x)))) * 0.0625f; g.y += (fminf(z.y, 0.f) - 0.6931471805599453f * __builtin_amdgcn_logf(1.0f + __builtin_amdgcn_exp2f(-1.4426950408889634f * fabsf(z.y)))) * 0.0625f;
                      const float e0 = __expf(g.x), e1 = __expf(g.y), i0 = __builtin_amdgcn_rcpf(e0), i1 = __builtin_amdgcn_rcpf(e1);
                      const unsigned qv = qv8[ii], kv = kv8[ii];
                      const float q0 = bf2f(qv & 0xffffu) * 0.0625f * e0, q1 = bf2f(qv >> 16) * 0.0625f * e1, k0 = bf2f(kv & 0xffffu) * i0, k1 = bf2f(kv >> 16) * i1;
                      const unsigned kb0 = f2bf(k0), kb1 = f2bf(k1);
                      *(unsigned*)(Qd + (size_t)(row0 + row) * 1024 + ch) = pk2(q0, q1);
                      *(unsigned*)(Kd + (size_t)(row0 + row) * 1024 + ch) = kb0 | (kb1 << 16);
                      kt0[ii] = kb0; kt1[ii] = kb1;
                  }
                  v4u o0, o1; const int grp = dir ? 7 - i8 : i8;
                  if (dir == 0) { o0.x = kt0[0] | (kt0[1] << 16); o0.y = kt0[2] | (kt0[3] << 16); o0.z = kt0[4] | (kt0[5] << 16); o0.w = kt0[6] | (kt0[7] << 16);
                                  o1.x = kt1[0] | (kt1[1] << 16); o1.y = kt1[2] | (kt1[3] << 16); o1.z = kt1[4] | (kt1[5] << 16); o1.w = kt1[6] | (kt1[7] << 16); }
                  else          { o0.x = kt0[7] | (kt0[6] << 16); o0.y = kt0[5] | (kt0[4] << 16); o0.z = kt0[3] | (kt0[2] << 16); o0.w = kt0[1] | (kt0[0] << 16);
                                  o1.x = kt1[7] | (kt1[6] << 16); o1.y = kt1[5] | (kt1[4] << 16); o1.z = kt1[3] | (kt1[2] << 16); o1.w = kt1[1] | (kt1[0] << 16); }
                  *(v4u*)(KTc + grp * 8) = o0; *(v4u*)(KTc + 64 + grp * 8) = o1;
              };
              gate_group(0);
#pragma unroll 1
              for (int i8 = 1; i8 < 8; ++i8) gate_group(i8);
              f32x2 eo; eo.x = __expf(g.x); eo.y = __expf(g.y);
              *(f32x2*)(EB + ((size_t)cu * 2 + dir) * 1024 + ch) = eo;
          } }
        VM_WAIT(); __syncthreads();
        { const int dir = F.wave >> 2, hd = F.wave & 3, l31 = F.lane & 31, hh = F.lane >> 5;
          const bf16* Qp = QK + (size_t)dir * 2 * MH * 1024 + (size_t)row0 * 1024 + hd * 256; const bf16* Kp = Qp + (size_t)MH * 1024;
          bf16* Pp = PB + (((size_t)cu * 2 + dir) * 4 + hd) * 4096;
#pragma unroll 1
          for (int t = 0; t < 4; ++t) { const int ti = t >> 1, tj = t & 1;
              f32x16 acc;
#pragma unroll
              for (int r = 0; r < 16; ++r) acc[r] = 0.f;
              const bool dead = dir ? (ti == 1 && tj == 0) : (ti == 0 && tj == 1);
              if (!dead) {
                  const bf16* qa = Qp + (size_t)(32 * ti + l31) * 1024 + 8 * hh; const bf16* ka = Kp + (size_t)(32 * tj + l31) * 1024 + 8 * hh;
#pragma unroll 1
                  for (int k8 = 0; k8 < 2; ++k8) { bf16x8 qf[8], kf[8];
#pragma unroll
                      for (int ks = 0; ks < 8; ++ks) { qf[ks] = *(const bf16x8*)(qa + (k8 * 8 + ks) * 16); kf[ks] = *(const bf16x8*)(ka + (k8 * 8 + ks) * 16); }
#pragma unroll
                      for (int ks = 0; ks < 8; ++ks) acc = MFMA32(kf[ks], qf[ks], acc); } }
              const int i = 32 * ti + l31;
#pragma unroll
              for (int r4 = 0; r4 < 4; ++r4) { const int j0 = 32 * tj + 8 * r4 + 4 * hh; float v[4];
#pragma unroll
                  for (int jj = 0; jj < 4; ++jj) { const int j = j0 + jj; const bool keep = dir ? (j >= i) : (j <= i); v[jj] = keep ? acc[4 * r4 + jj] : 0.f; }
                  v2u o; o.x = pk2(v[0], v[1]); o.y = pk2(v[2], v[3]); *(v2u*)(Pp + i * 64 + j0) = o; }
          } }
        { const int nc = S >> 6, b = cu / nc, c = cu - b * nc, lane = F.lane; const size_t seq0 = (size_t)b * S;
          f32x4 fgv[4][2];
#pragma unroll
          for (int g = 0; g < 4; ++g) { fgv[g][0] = *(const f32x4*)(fg + g * 512 + lane * 8); fgv[g][1] = *(const f32x4*)(fg + g * 512 + lane * 8 + 4); }
          for (int t0 = F.wave * 8; t0 < 128; t0 += NWAVES * 8) {
              v4u ra[8], rb[8];
#pragma unroll
              for (int q4 = 0; q4 < 8; ++q4) { const int t = t0 + q4, r = 32 * c + (t >> 2), g = t & 3, r2 = (S - r) & (S - 1);
                  ra[q4] = *(const v4u*)(proj + (seq0 + r) * 8192 + g * 512 + lane * 8); rb[q4] = *(const v4u*)(proj + (seq0 + r2) * 8192 + g * 512 + lane * 8); }
#pragma unroll
              for (int q4 = 0; q4 < 8; ++q4) { const int t = t0 + q4, r = 32 * c + (t >> 2), g = t & 3;
                  float v1[8], v2[8];
#pragma unroll
                  for (int j = 0; j < 4; ++j) { v1[2 * j] = bf2f(ra[q4][j] & 0xffffu); v1[2 * j + 1] = bf2f(ra[q4][j] >> 16); v2[2 * j] = bf2f(rb[q4][j] & 0xffffu); v2[2 * j + 1] = bf2f(rb[q4][j] >> 16); }
                  float s1 = 0.f, s2 = 0.f;
#pragma unroll
                  for (int j = 0; j < 8; ++j) { s1 += v1[j]; s2 += v2[j]; }
                  const float m1 = wave_sum(s1) * (1.0f / 512.0f), m2 = wave_sum(s2) * (1.0f / 512.0f); float q1 = 0.f, q2 = 0.f;
#pragma unroll
                  for (int j = 0; j < 8; ++j) { v1[j] -= m1; q1 += v1[j] * v1[j]; v2[j] -= m2; q2 += v2[j] * v2[j]; }
                  const float r1 = rsqrtf(wave_sum(q1) * (1.0f / 512.0f) + LN_EPS), r2s = rsqrtf(wave_sum(q2) * (1.0f / 512.0f) + LN_EPS);
                  const f32x4 g0 = fgv[q4 & 3][0], g1 = fgv[q4 & 3][1];
                  float e[8], o[8];
#pragma unroll
                  for (int j = 0; j < 8; ++j) { const float gg = (j < 4) ? g0[j & 3] : g1[j & 3]; const float a1 = v1[j] * r1 * gg, a2 = (r == 0) ? 0.f : v2[j] * r2s * gg; e[j] = a1 + a2; o[j] = a1 - a2; }
                  bf16* fb = un + ((size_t)(b * 4 + g) * S + r) * 512 + lane * 8;
                  v4u we; we.x = pk2(e[0], e[1]); we.y = pk2(e[2], e[3]); we.z = pk2(e[4], e[5]); we.w = pk2(e[6], e[7]);
                  *(v4u*)fb = we;
                  if (r != 0) { v4u wo; wo.x = pk2(o[0], o[1]); wo.y = pk2(o[2], o[3]); wo.z = pk2(o[4], o[5]); wo.w = pk2(o[6], o[7]); *(v4u*)(fb + (size_t)(S >> 1) * 512) = wo; }
              } }
          LAS float* nyl = (LAS float*)(F.lds + RING_OFF + 16384);
          if (F.wave < 4) { const int g = F.wave; const v4u raw = *(const v4u*)(proj + (seq0 + (S >> 1)) * 8192 + g * 512 + lane * 8);
              float v[8];
#pragma unroll
              for (int j = 0; j < 4; ++j) { v[2 * j] = bf2f(raw[j] & 0xffffu); v[2 * j + 1] = bf2f(raw[j] >> 16); }
              float sm = 0.f;
#pragma unroll
              for (int j = 0; j < 8; ++j) sm += v[j];
              const float mean = wave_sum(sm) * (1.0f / 512.0f); float q = 0.f;
#pragma unroll
              for (int j = 0; j < 8; ++j) { v[j] -= mean; q += v[j] * v[j]; }
              const float rstd = rsqrtf(wave_sum(q) * (1.0f / 512.0f) + LN_EPS);
              const f32x4 g0 = *(const f32x4*)(fg + g * 512 + lane * 8), g1 = *(const f32x4*)(fg + g * 512 + lane * 8 + 4);
              f32x4 n0, n1;
#pragma unroll
              for (int j = 0; j < 4; ++j) { n0[j] = v[j] * rstd * g0[j]; n1[j] = v[4 + j] * rstd * g1[j]; }
              *(LAS f32x4*)(nyl + g * 512 + lane * 8) = n0; *(LAS f32x4*)(nyl + g * 512 + lane * 8 + 4) = n1;
              if (c == 0) *(v4u*)(un + ((size_t)(b * 4 + g) * S + (S >> 1)) * 512 + lane * 8) = (v4u){0u, 0u, 0u, 0u}; }
          __syncthreads();
          { const int sl = 512 / nc; const float isq = rsqrtf((float)S);
            for (int idx = F.wave; idx < 4 * sl; idx += NWAVES) { const int g = idx / sl, cp = c * sl + idx % sl;
                const v4u dw = *(const v4u*)(Dc + (size_t)cp * 512 + lane * 8);
                const f32x4 n0 = *(const LAS f32x4*)(nyl + g * 512 + lane * 8), n1 = *(const LAS f32x4*)(nyl + g * 512 + lane * 8 + 4);
                float d = bf2f(dw.x & 0xffffu) * n0[0] + bf2f(dw.x >> 16) * n0[1] + bf2f(dw.y & 0xffffu) * n0[2] + bf2f(dw.y >> 16) * n0[3]
                        + bf2f(dw.z & 0xffffu) * n1[0] + bf2f(dw.z >> 16) * n1[1] + bf2f(dw.w & 0xffffu) * n1[2] + bf2f(dw.w >> 16) * n1[3];
                d = wave_sum(d);
                if (lane == 0) nyq[(b * 4 + g) * 512 + cp] = d * isq; } } }
        __syncthreads();
    }
}

constexpr int GS_VT = 0, GS_VT_P = 72, GS_ST = 9216, GS_ST_P = 264, GS_RED = GS_ST + 64 * GS_ST_P * 2, GS_PL = GS_RED + 16384, GS_PL_P = 72, GS_EL = GS_PL + 64 * GS_PL_P * 2, GS_QL = GS_EL + 1024, GS_QL_P = 264, GS_KL = GS_QL + 64 * GS_QL_P * 2, GS_KL_P = 72, GS_END = GS_KL + 256 * GS_KL_P * 2;
static_assert(GS_RED % 16 == 0 && GS_PL % 16 == 0 && GS_EL % 16 == 0 && GS_QL % 16 == 0 && GS_KL % 16 == 0 && GS_END <= LDSCTL_OFF, "scan LDS map");
#define WG_BAR() do { asm volatile("s_waitcnt lgkmcnt(0)" ::: "memory"); __builtin_amdgcn_s_barrier(); asm volatile("" ::: "memory"); } while (0)
struct ScanOps { v4u pv, pp, pq[4], pk[4]; f32x4 pe; };
__device__ __forceinline__ void scan_load(ScanOps& o, const bf16* proj, const bf16* Qd, const bf16* KTd, const bf16* PB, const float* EB, int cg, int dir, int hd, int slab, int tid, int w, int l31, int hh, int ti, int kh) {
    const int row0 = cg * 64, tok = tid >> 3, c8 = tid & 7;
    o.pv = *(const v4u*)(proj + (size_t)(row0 + tok) * 8192 + 4096 + hd * 512 + slab * 64 + c8 * 8);
    o.pp = *(const v4u*)(PB + (((size_t)cg * 2 + dir) * 4 + hd) * 4096 + tok * 64 + c8 * 8);
    o.pe = *(const f32x4*)(EB + ((size_t)cg * 2 + dir) * 1024 + hd * 256 + 4 * (tid & 63));
#pragma unroll
    for (int i = 0; i < 4; ++i) { const int c = tid + 512 * i; o.pq[i] = *(const v4u*)(Qd + (size_t)(row0 + (c >> 5)) * 1024 + hd * 256 + (c & 31) * 8); }
    const bf16* ka = KTd + ((size_t)cg * 1024 + hd * 256) * 64;
#pragma unroll
    for (int i = 0; i < 4; ++i) o.pk[i] = *(const v4u*)(ka + (size_t)(tid + 512 * i) * 8);
}
__device__ __forceinline__ void gla_scan_phase(Frame& F, const bf16* proj, const bf16* QK, const bf16* KT, const bf16* PB, const float* EB, bf16* O, int S, int nb, int ostride, int hmask) {
    frame_refresh(F);
    LAS bf16* VT = (LAS bf16*)(F.lds + RING_OFF + GS_VT); LAS bf16* ST = (LAS bf16*)(F.lds + RING_OFF + GS_ST); LAS float* RED = (LAS float*)(F.lds + RING_OFF + GS_RED);
    LAS bf16* PL = (LAS bf16*)(F.lds + RING_OFF + GS_PL); LAS float* EL = (LAS float*)(F.lds + RING_OFF + GS_EL); LAS bf16* QL = (LAS bf16*)(F.lds + RING_OFF + GS_QL); LAS bf16* KL = (LAS bf16*)(F.lds + RING_OFF + GS_KL);
    const int nc = S / 64, nunits = nb * 64;
    const int w = F.wave, l31 = F.lane & 31, hh = F.lane >> 5;
    const int t = w & 3, ti = t >> 1, tj = t & 1, kh = w >> 2;
    for (int u = blockIdx.x; u < nunits; u += F.G) {
        const int slab = u & 7, dir = (u >> 3) & 1, hd = (u >> 4) & 3, b = u >> 6;
        const bf16* Qd = QK + (size_t)dir * 2 * MH * 1024; const bf16* KTd = KT + (size_t)dir * (MH / 64) * 1024 * 64;
        f32x16 s0, s1;
#pragma unroll
        for (int r = 0; r < 16; ++r) { s0[r] = 0.f; s1[r] = 0.f; }
        ScanOps cur, nxt;
        f32x16 pend; bf16* pend_op = O; bool have_pend = false;
#pragma unroll
        for (int r = 0; r < 16; ++r) pend[r] = 0.f;
        scan_load(cur, proj, Qd, KTd, PB, EB, b * nc + (dir ? nc - 1 : 0), dir, hd, slab, F.tid, w, l31, hh, ti, kh);
        nxt = cur;
#pragma unroll 1
        for (int step = 0; step < nc; ++step) {
            const int c = dir ? nc - 1 - step : step, cg = b * nc + c, row0 = cg * 64;
            { const int tok = F.tid >> 3, c8 = F.tid & 7;
              v4u rot = cur.pv;
              if (c8 & 4) rot = (v4u){rot[2], rot[3], rot[0], rot[1]};
              if (c8 & 2) rot = (v4u){rot[1], rot[2], rot[3], rot[0]};
              if (c8 & 1) rot = (v4u){__builtin_amdgcn_alignbit(rot[1], rot[0], 16), __builtin_amdgcn_alignbit(rot[2], rot[1], 16), __builtin_amdgcn_alignbit(rot[3], rot[2], 16), __builtin_amdgcn_alignbit(rot[0], rot[3], 16)};
#pragma unroll
              for (int j = 0; j < 8; ++j) { const int e = (j + c8) & 7; VT[(c8 * 8 + e) * GS_VT_P + tok] = (bf16)((j & 1) ? (rot[j >> 1] >> 16) : (rot[j >> 1] & 0xffffu)); }
              *(LAS v4u*)(PL + tok * GS_PL_P + c8 * 8) = cur.pp;
#pragma unroll
              for (int i = 0; i < 4; ++i) { const int c = F.tid + 512 * i; *(LAS v4u*)(QL + (c >> 5) * GS_QL_P + (c & 31) * 8) = cur.pq[i]; *(LAS v4u*)(KL + (c >> 3) * GS_KL_P + (c & 7) * 8) = cur.pk[i]; }
              if (F.tid < 64) *(LAS f32x4*)(EL + 4 * F.tid) = cur.pe; }
#pragma unroll
            for (int r4 = 0; r4 < 4; ++r4) { const int dk = 32 * w + 8 * r4 + 4 * hh;
                v2u o0, o1; o0.x = pk2(s0[4 * r4], s0[4 * r4 + 1]); o0.y = pk2(s0[4 * r4 + 2], s0[4 * r4 + 3]); o1.x = pk2(s1[4 * r4], s1[4 * r4 + 1]); o1.y = pk2(s1[4 * r4 + 2], s1[4 * r4 + 3]);
                *(LAS v2u*)(ST + l31 * GS_ST_P + dk) = o0; *(LAS v2u*)(ST + (32 + l31) * GS_ST_P + dk) = o1; }
            WG_BAR();
            if (kh == 0 && have_pend) {
#pragma unroll
                for (int r = 0; r < 16; ++r) pend_op[(size_t)crow(r, hh) * ostride] = (bf16)f2bf(pend[r]); }
            if (step + 1 < nc) scan_load(nxt, proj, Qd, KTd, PB, EB, b * nc + (dir ? nc - 2 - step : step + 1), dir, hd, slab, F.tid, w, l31, hh, ti, kh);
            f32x16 acc;
#pragma unroll
            for (int r = 0; r < 16; ++r) acc[r] = 0.f;
            { const LAS bf16* sb = ST + (32 * tj + l31) * GS_ST_P + kh * 128 + 8 * hh;
              bf16x8 bs[4];
#pragma unroll
              for (int ks = 0; ks < 4; ++ks) bs[ks] = *(const LAS bf16x8*)(sb + ks * 16);
              const LAS bf16* vb0 = VT + l31 * GS_VT_P + 8 * hh; const LAS bf16* vb1 = VT + (32 + l31) * GS_VT_P + 8 * hh;
              bf16x8 v0[4], v1[4];
#pragma unroll
              for (int ks = 0; ks < 4; ++ks) { v0[ks] = *(const LAS bf16x8*)(vb0 + ks * 16); v1[ks] = *(const LAS bf16x8*)(vb1 + ks * 16); }
              const LAS bf16* qb = QL + (32 * ti + l31) * GS_QL_P + kh * 128 + 8 * hh;
              bf16x8 qs[4];
#pragma unroll
              for (int ks = 0; ks < 4; ++ks) qs[ks] = *(const LAS bf16x8*)(qb + ks * 16);
#pragma unroll
              for (int ks = 0; ks < 4; ++ks) acc = MFMA32(qs[ks], bs[ks], acc);
#pragma unroll
              for (int ks = 0; ks < 4; ++ks) { bs[ks] = *(const LAS bf16x8*)(sb + (ks + 4) * 16); qs[ks] = *(const LAS bf16x8*)(qb + (ks + 4) * 16); }
#pragma unroll
              for (int ks = 0; ks < 4; ++ks) acc = MFMA32(qs[ks], bs[ks], acc);
              { const LAS bf16* kb = KL + (32 * w + l31) * GS_KL_P + 8 * hh;
#pragma unroll
                for (int ks = 0; ks < 4; ++ks) qs[ks] = *(const LAS bf16x8*)(kb + ks * 16); }
#pragma unroll
              for (int ks = 0; ks < 4; ++ks) { s0 = MFMA32(qs[ks], v0[ks], s0); s1 = MFMA32(qs[ks], v1[ks], s1); }
              if (kh == 0) { const LAS bf16* pa = PL + (32 * ti + l31) * GS_PL_P + 8 * hh; bf16x8 pf[4];
#pragma unroll
                  for (int ks = 0; ks < 4; ++ks) pf[ks] = *(const LAS bf16x8*)(pa + ks * 16);
#pragma unroll
                  for (int ks = 0; ks < 4; ++ks) acc = MFMA32(pf[ks], tj ? v1[ks] : v0[ks], acc); }
#pragma unroll
              for (int r4 = 0; r4 < 4; ++r4) { const f32x4 e = *(const LAS f32x4*)(EL + 32 * w + 8 * r4 + 4 * hh);
#pragma unroll
                  for (int jj = 0; jj < 4; ++jj) { s0[4 * r4 + jj] *= e[jj]; s1[4 * r4 + jj] *= e[jj]; } } }
            if (kh == 1) {
#pragma unroll
                for (int r = 0; r < 16; ++r) RED[t * 1024 + r * 64 + F.lane] = acc[r]; }
            WG_BAR();
            if (kh == 0) { pend_op = O + (size_t)dir * MH * 2048 + (size_t)(row0 + 32 * ti) * ostride + (hd & hmask) * 512 + slab * 64 + 32 * tj + l31; have_pend = true;
#pragma unroll
                for (int r = 0; r < 16; ++r) pend[r] = acc[r] + RED[t * 1024 + r * 64 + F.lane]; }
            cur = nxt;
        }
        if (kh == 0 && have_pend) {
#pragma unroll
            for (int r = 0; r < 16; ++r) pend_op[(size_t)crow(r, hh) * ostride] = (bf16)f2bf(pend[r]); }
        WG_BAR();
    }
}
constexpr int AT_KP = 72, AT_VP = 392, AT_BP = 264;
constexpr int AT_K = 0, AT_V = 384 * AT_KP * 2, AT_B = AT_V + 64 * AT_VP * 2, AT_END = AT_B + 8 * AT_BP * 4;
static_assert(AT_V % 16 == 0 && AT_B % 16 == 0 && AT_END <= RING_BYTES, "attention LDS map");
__device__ __forceinline__ unsigned cvtpk(float lo, float hi) { f32x2_t v = {lo, hi}; bf16x2_t b = __builtin_convertvector(v, bf16x2_t); return __builtin_bit_cast(unsigned, b); }
__device__ __forceinline__ void attn_phase(Frame& F, const bf16* cp, const float* table, const float* sinks, bf16* ao) {
    frame_refresh(F);
    LAS bf16* KL = (LAS bf16*)(F.lds + RING_OFF + AT_K); LAS bf16* VT = (LAS bf16*)(F.lds + RING_OFF + AT_V); LAS float* BL = (LAS float*)(F.lds + RING_OFF + AT_B);
    const float L2E = 1.4426950408889634f, C1 = 0.125f * 1.4426950408889634f;
    const int w = F.wave, l31 = F.lane & 31, hh = F.lane >> 5;
    for (int u = blockIdx.x; u < (M / 128) * 8; u += F.G) {
        const int kvh = u & 7, qb = u >> 3, row0 = qb * 128;
        int S, p0; if (row0 < MH) { S = 2048; p0 = row0 & 2047; } else { S = 4096; p0 = (row0 - MH) & 4095; }
        const bool lo_ok = p0 > 0, hi_ok = p0 + 128 < S;
        v4u kvr[6], vvr[6];
#pragma unroll
        for (int it = 0; it < 6; ++it) { const int c = F.tid + 512 * it, wr = c >> 3, c8 = c & 7;
            const bool valid = (wr >= 128 || lo_ok) && (wr < 256 || hi_ok);
            kvr[it] = (v4u){0u, 0u, 0u, 0u}; vvr[it] = kvr[it];
            if (valid) { const bf16* src = cp + (size_t)(row0 - 128 + wr) * C_IN + 4096 + kvh * 64 + c8 * 8; kvr[it] = *(const v4u*)src; vvr[it] = *(const v4u*)(src + 512); } }
#pragma unroll
        for (int it = 0; it < 6; ++it) { const int c = F.tid + 512 * it, wr = c >> 3, c8 = c & 7;
            *(LAS v4u*)(KL + wr * AT_KP + c8 * 8) = kvr[it];
            v4u rot = vvr[it];
            if (c8 & 4) rot = (v4u){rot[2], rot[3], rot[0], rot[1]};
            if (c8 & 2) rot = (v4u){rot[1], rot[2], rot[3], rot[0]};
            if (c8 & 1) rot = (v4u){__builtin_amdgcn_alignbit(rot[1], rot[0], 16), __builtin_amdgcn_alignbit(rot[2], rot[1], 16), __builtin_amdgcn_alignbit(rot[3], rot[2], 16), __builtin_amdgcn_alignbit(rot[0], rot[3], 16)};
#pragma unroll
            for (int j = 0; j < 8; ++j) { const int e = (j + c8) & 7; VT[(c8 * 8 + e) * AT_VP + wr] = (bf16)((j & 1) ? (rot[j >> 1] >> 16) : (rot[j >> 1] & 0xffffu)); } }
        for (int e = F.tid; e < 8 * 257; e += 512) { const int hw = e / 257, t = e - hw * 257; BL[hw * AT_BP + t] = table[t5_bucket(t - 128) * 64 + kvh * 8 + hw] * L2E; }
        const int h = kvh * 8 + w; const float sink2 = sinks[h] * L2E;
        bf16x8 qn[4];
#pragma unroll
        for (int ks = 0; ks < 4; ++ks) qn[ks] = *(const bf16x8*)(cp + (size_t)(row0 + l31) * C_IN + h * 64 + 16 * ks + 8 * hh);
        __syncthreads();
#pragma unroll 1
        for (int qi = 0; qi < 4; ++qi) {
            const int qrow = row0 + 32 * qi + l31;
            bf16x8 qf[4];
#pragma unroll
            for (int ks = 0; ks < 4; ++ks) qf[ks] = qn[ks];
            if (qi < 3) {
#pragma unroll
                for (int ks = 0; ks < 4; ++ks) qn[ks] = *(const bf16x8*)(cp + (size_t)(qrow + 32) * C_IN + h * 64 + 16 * ks + 8 * hh); }
            float m = sink2, lsum = hh ? 0.f : 1.f;
            f32x16 o0, o1;
#pragma unroll
            for (int r = 0; r < 16; ++r) { o0[r] = 0.f; o1[r] = 0.f; }
#pragma unroll 3
            for (int kj = qi; kj <= qi + 8; ++kj) {
                if ((kj < 4 && !lo_ok) || (kj >= 8 && !hi_ok)) continue;
                f32x16 s;
#pragma unroll
                for (int r = 0; r < 16; ++r) s[r] = 0.f;
#pragma unroll
                for (int ks = 0; ks < 4; ++ks) { const bf16x8 kf = *(const LAS bf16x8*)(KL + (32 * kj + l31) * AT_KP + 16 * ks + 8 * hh); s = MFMA32(kf, qf[ks], s); }
                const int tb = 32 * (kj - qi) - l31;
                float mx = -INFINITY;
                if (kj == qi || kj == qi + 8) {
#pragma unroll
                    for (int r = 0; r < 16; ++r) { const int t = tb + crow(r, hh); const int tc = t < 0 ? 0 : (t > 256 ? 256 : t);
                        float x = fmaf(s[r], C1, BL[w * AT_BP + tc]); x = (t == tc) ? x : -INFINITY; s[r] = x; mx = fmaxf(mx, x); }
                } else {
#pragma unroll
                    for (int r = 0; r < 16; ++r) { const float x = fmaf(s[r], C1, BL[w * AT_BP + tb + crow(r, hh)]); s[r] = x; mx = fmaxf(mx, x); }
                }
                mx = fmaxf(mx, __shfl_xor(mx, 32));
                if (__builtin_amdgcn_ballot_w64(mx > m + 8.0f) != 0ull) {
                    const float mn = fmaxf(m, mx), sc = __builtin_amdgcn_exp2f(m - mn); m = mn; lsum *= sc;
#pragma unroll
                    for (int r = 0; r < 16; ++r) { o0[r] *= sc; o1[r] *= sc; }
                }
                float ps = 0.f;
#pragma unroll
                for (int r = 0; r < 16; ++r) { const float p = __builtin_amdgcn_exp2f(s[r] - m); s[r] = p; ps += p; }
                lsum += ps;
#pragma unroll
                for (int s2 = 0; s2 < 2; ++s2) {
                    v4u pw; pw.x = cvtpk(s[8 * s2], s[8 * s2 + 1]); pw.y = cvtpk(s[8 * s2 + 2], s[8 * s2 + 3]); pw.z = cvtpk(s[8 * s2 + 4], s[8 * s2 + 5]); pw.w = cvtpk(s[8 * s2 + 6], s[8 * s2 + 7]);
                    const bf16x8 pb = __builtin_bit_cast(bf16x8, pw);
                    const LAS bf16* v0 = VT + l31 * AT_VP + 32 * kj + 16 * s2 + 4 * hh; const LAS bf16* v1 = v0 + 32 * AT_VP;
                    const v2u a00 = *(const LAS v2u*)v0, a01 = *(const LAS v2u*)(v0 + 8), a10 = *(const LAS v2u*)v1, a11 = *(const LAS v2u*)(v1 + 8);
                    const v4u va0 = (v4u){a00.x, a00.y, a01.x, a01.y}, va1 = (v4u){a10.x, a10.y, a11.x, a11.y};
                    o0 = MFMA32(__builtin_bit_cast(bf16x8, va0), pb, o0); o1 = MFMA32(__builtin_bit_cast(bf16x8, va1), pb, o1);
                }
            }
            const float inv = 1.0f / (lsum + __shfl_xor(lsum, 32));
            bf16* op = ao + (size_t)qrow * D + h * 64 + 4 * hh;
#pragma unroll
            for (int r4 = 0; r4 < 4; ++r4) {
                v2u a, b; a.x = cvtpk(o0[4 * r4] * inv, o0[4 * r4 + 1] * inv); a.y = cvtpk(o0[4 * r4 + 2] * inv, o0[4 * r4 + 3] * inv);
                b.x = cvtpk(o1[4 * r4] * inv, o1[4 * r4 + 1] * inv); b.y = cvtpk(o1[4 * r4 + 2] * inv, o1[4 * r4 + 3] * inv);
                *(v2u*)(op + 8 * r4) = a; *(v2u*)(op + 32 + 8 * r4) = b; }
        }
        __syncthreads();
    }
}
struct Args { const float* in[17]; float* out; unsigned char* ws; int ph_lo, ph_hi; };
constexpr int N_PHASES = 20;
__global__ void __launch_bounds__(NWAVES * 64, 2) mega_fwd(Args args) {
    extern __shared__ __attribute__((aligned(16))) unsigned char lds[];
    Frame F;
    F.lds = (LAS unsigned char*)lds;
    F.MISC = (volatile LAS unsigned*)(F.lds + MISC_OFF);
    F.tid = threadIdx.x; F.lane = F.tid & 63; F.wave = __builtin_amdgcn_readfirstlane(F.tid >> 6);
    F.G = gridDim.x; F.gw = blockIdx.x * NWAVES + F.wave; F.NGW = F.G * NWAVES;
    unsigned char* ws = args.ws;
    F.ctl = (unsigned*)(ws + WS_CTL);
    for (int u = F.tid; u < (LDS_BYTES - LDSCTL_OFF) / 4; u += NWAVES * 64) ((LAS unsigned*)(F.lds + LDSCTL_OFF))[u] = 0u;
    __syncthreads();
    XcdBarrier bar = xcd_barrier_post(F.ctl + CW_BAR, F.MISC + 8);

    const float* x_prompt = args.in[0]; const float* x_sample = args.in[1]; const float* table = args.in[2];
    const float* ab_w_in = args.in[3]; const float* ab_fg = args.in[4]; const float* ab_w2 = args.in[5]; const float* ab_gb = args.in[6];
    const float* ab_hg = args.in[7]; const float* ab_w_out = args.in[8]; const float* c_w_in = args.in[9]; const float* c_sinks = args.in[10];
    const float* c_w_out = args.in[11]; const float* ffn_w1 = args.in[12]; const float* ffn_w3 = args.in[13]; const float* ffn_w2 = args.in[14];
    const float* ln_g = args.in[15]; const float* ln_b = args.in[16];
    float* out = args.out;
    bf16 *Win = (bf16*)(ws + WS_WIN), *Wout = (bf16*)(ws + WS_WOUT), *Cin = (bf16*)(ws + WS_CIN), *Cout = (bf16*)(ws + WS_COUT), *Dc = (bf16*)(ws + WS_DFTC), *DsP = (bf16*)(ws + WS_DFTP), *DsS = (bf16*)(ws + WS_DFTS);
    bf16 *W13 = (bf16*)(ws + WS_W13), *W2 = (bf16*)(ws + WS_W2), *xb = (bf16*)(ws + WS_XB), *W13b = (bf16*)(ws + WS_W13_L1), *W2b = (bf16*)(ws + WS_W2_L1);
    bf16 *proj = (bf16*)(ws + WS_PROJ), *un = (bf16*)(ws + WS_UN), *ucs = (bf16*)(ws + WS_UCS), *mix = (bf16*)(ws + WS_MIX);
    float *EB = (float*)(ws + WS_EB); bf16* O = (bf16*)(ws + WS_O);
    float* stats = (float*)(ws + WS_STATS); float* csv = (float*)(ws + WS_CS);
    bf16 *QK = (bf16*)(ws + WS_QK), *KT = (bf16*)(ws + WS_KT), *PB = (bf16*)(ws + WS_PB);
    bf16 *hid = (bf16*)(ws + WS_HID), *cproj = (bf16*)(ws + WS_CPROJ), *atto = (bf16*)(ws + WS_ATTO);

    const int lo = args.ph_lo, hi = args.ph_hi;
#define IN(k) (lo <= (k) && (k) < hi)
#define SEAM(k) do { if (IN(k) && IN((k) + 1)) xcd_barrier(bar); } while (0)
    typedef pg8::StaticOrder SO;

    if (IN(0)) {
        cvt_rows_bf16(F, x_prompt, xb, (size_t)MH * D / 8);
        cvt_rows_bf16(F, x_sample, xb + (size_t)MH * D, (size_t)MH * D / 8);
        cvt_weight(F, ab_w_in, D, AB_IN, Win, 0, 0);
        cvt_weight(F, ab_w_out, D, D, Wout, 0, 0);
        gen_dftc(F, Dc); gen_dfts(F, DsP, 11); gen_dfts(F, DsS, 12);
        __syncthreads();
    }
    SEAM(0);
#pragma unroll 1
    for (int half = 0; half < 2; ++half) {
        const int pb = 1 + 5 * half;
        const int lgS = half ? 12 : 11, S = 1 << lgS, nb = half ? 4 : 8, nz = nb * 4;
        const bf16* xbh = xb + (size_t)half * MH * D; bf16* mixh = mix + (size_t)half * MH * D; const bf16* Ds = half ? DsS : DsP;
        if (IN(pb)) {
            const bool early = ((int)blockIdx.x & 1) != 0;
#pragma unroll 1
            for (int pass = 0; pass < 2; ++pass) {
                if ((pass == 0) == early) {
                    __syncthreads();
                    if (half == 0) {
                        cvt_weight_fold(F, ffn_w1, D, DFF, W13, 128, 0, ln_g, ln_b, csv + CS13, csv + BW13);
                        cvt_weight_fold(F, ffn_w3, D, DFF, W13, 128, 1, ln_g, ln_b, csv + CS13, csv + BW13);
                    } else {
                        cvt_weight(F, ffn_w2, DFF, D, W2, 0, 0);
                        cvt_weight_fold(F, c_w_in, D, C_IN, Cin, 0, 0, ln_g + D, ln_b + D, csv + CSC, csv + BWC);
                        cvt_weight(F, c_w_out, D, D, Cout, 0, 0);
                    }
                    __syncthreads();
                }
                if (pass == 0) {
                    pg8::Gemm g{xbh, Win, MH, 8192, D}; SO So; So.init(MH, 8192, F.G, (int)blockIdx.x);
                    pg8::EpiStoreBf E{proj, 8192};
                    pg8::gemm_phase<pg8::EpiStoreBf, SO, true, true>(F.lds + RING_OFF, g, So, E);
                }
            }
        }
        SEAM(pb);
        if (IN(pb + 1)) p2_phase(F, xbh, Win + (size_t)8192 * D, ab_w2, ab_gb, proj, ab_fg, un, QK, KT, PB, EB, Dc, csv + NYQ, S);
        SEAM(pb + 1);
        if (IN(pb + 2)) {
            pg8::Gemm g{Dc, un, 1024, nz * S, 512}; pg8::FoldOrder So; So.init(512, nz * S, F.G, (int)blockIdx.x); So.lgS = lgS;
            pg8::EpiF1 E{ucs, lgS};
            pg8::gemm_phase<pg8::EpiF1, pg8::FoldOrder, true, true>(F.lds + RING_OFF, g, So, E);
        }
        SEAM(pb + 2);
        if (IN(pb + 3)) {
            { pg8::Gemm g{Ds, ucs, S / 2, nz * 512, S}; SO So; So.init(S / 2, nz * 512, F.G, (int)blockIdx.x);
            pg8::EpiF2 E{mixh, S, csv + NYQ};
            pg8::gemm_phase<pg8::EpiF2, SO, true, true>(F.lds + RING_OFF, g, So, E);
            __syncthreads(); }
            gla_scan_phase(F, proj, QK, KT, PB, EB, O, S, nb, 2048, 3);
        }
        SEAM(pb + 3);
        if (IN(pb + 4)) { f2_mid_row(F, ucs, csv + NYQ, mixh, S, nz); headnorm_phase(F, O, proj, ab_hg, mixh); }
        SEAM(pb + 4);
    }
#pragma unroll 1
    for (int layer = 0; layer < 2; ++layer) {
        const int ob = layer ? 16 : 11;
        float* st_mix = stats + (size_t)(2 * layer) * 2 * M;
        float* st_ffn = stats + (size_t)1 * 2 * M;
        if (layer == 1) {
            if (IN(14)) {
                pg8::Gemm g{xb, Cin, M, C_IN, D}; SO So; So.init(M, C_IN, F.G, (int)blockIdx.x);
                pg8::EpiStoreBfFold E{cproj, C_IN, st_ffn, csv + CSC, csv + BWC};
                pg8::gemm_phase<pg8::EpiStoreBfFold, SO, true, true>(F.lds + RING_OFF, g, So, E);
            }
            SEAM(14);
            if (IN(15)) attn_phase(F, cproj, table, c_sinks, atto);
            SEAM(15);
        }
        if (IN(ob)) {
            pg8::Gemm g{layer ? atto : mix, layer ? Cout : Wout, M, D, D}; SO So; So.init(M, D, F.G, (int)blockIdx.x);
            if (layer == 0) { pg8::EpiResid<false> E{x_prompt, x_sample - (size_t)MH * D, nullptr, nullptr, xb, nullptr, nullptr, nullptr, st_mix, ALPHA};
                pg8::gemm_phase<pg8::EpiResid<false>, SO, true, true>(F.lds + RING_OFF, g, So, E);
 }
            else { pg8::EpiResid<true> E{nullptr, nullptr, nullptr, xb, xb, st_ffn, ln_g + D, ln_b + D, st_mix, ALPHA};
                pg8::gemm_phase<pg8::EpiResid<true>, SO, true, true>(F.lds + RING_OFF, g, So, E); }
        }
        SEAM(ob);
        if (IN(ob + 1)) {
            const bool early = ((int)blockIdx.x & 1) != 0;
#pragma unroll 1
            for (int pass = 0; pass < 2; ++pass) {
                if ((pass == 0) == early) {
                    __syncthreads();
                    if (layer == 0) {
                        cvt_weight_fold(F, ffn_w1 + (size_t)D * DFF, D, DFF, W13b, 128, 0, ln_g + 2 * D, ln_b + 2 * D, csv + CS13_L1, csv + BW13_L1);
                        cvt_weight_fold(F, ffn_w3 + (size_t)D * DFF, D, DFF, W13b, 128, 1, ln_g + 2 * D, ln_b + 2 * D, csv + CS13_L1, csv + BW13_L1);
                    } else cvt_weight(F, ffn_w2 + (size_t)DFF * D, DFF, D, W2b, 0, 0);
                    __syncthreads();
                }
                if (pass == 0) {
                    pg8::Gemm g{xb, layer ? W13b : W13, M, 2 * DFF, D}; SO So; So.init(M, 2 * DFF, F.G, (int)blockIdx.x);
                    pg8::EpiSwiGLU E{hid, DFF, st_mix, csv + (layer ? CS13_L1 : CS13), csv + (layer ? BW13_L1 : BW13)};
                    pg8::gemm_phase<pg8::EpiSwiGLU, SO, true, true>(F.lds + RING_OFF, g, So, E);
                }
            }
        }
        SEAM(ob + 1);
        if (IN(ob + 2)) {
            pg8::Gemm g{hid, layer ? W2b : W2, M, D, DFF}; pg8::ReverseOrder So; So.init(M, D, F.G, (int)blockIdx.x);
            pg8::EpiResid<true> E{nullptr, nullptr, layer ? out : nullptr, xb, layer ? nullptr : xb, st_mix, ln_g + (size_t)(2 * layer) * D, ln_b + (size_t)(2 * layer) * D, layer ? nullptr : st_ffn, ALPHA};
            pg8::gemm_phase<pg8::EpiResid<true>, pg8::ReverseOrder, true, true>(F.lds + RING_OFF, g, So, E);
        }
        SEAM(ob + 2);
        if (layer == 1) {
            if (IN(19)) ln_phase(F, out, out, ln_g + 3 * D, ln_b + 3 * D, (bf16*)nullptr);
        }
    }
#undef IN
#undef SEAM
}

extern "C" void kernel_launch(void* const* d_in, const int* in_sizes, int n_in, void* d_out, int out_size, void* d_ws, size_t ws_size, hipStream_t stream) {
    static int grid = 0;
    if (grid == 0) {
        if (n_in != 17 || out_size != M * D || ws_size < WS_NEED) { fprintf(stderr, "kernel_launch: unexpected sizes: n_in %d out %d ws %zu (need %zu); nothing launched\n", n_in, out_size, ws_size, (size_t)WS_NEED); grid = -1; return; }
        int dev = 0, cus = 0, per_cu = 0;
        if (hipGetDevice(&dev) != hipSuccess || hipDeviceGetAttribute(&cus, hipDeviceAttributeMultiprocessorCount, dev) != hipSuccess) { fprintf(stderr, "kernel_launch: device query failed\n"); grid = -1; return; }
        if (hipFuncSetAttribute((const void*)mega_fwd, hipFuncAttributeMaxDynamicSharedMemorySize, LDS_BYTES) != hipSuccess) { fprintf(stderr, "kernel_launch: hipFuncSetAttribute failed\n"); grid = -1; return; }
        if (hipOccupancyMaxActiveBlocksPerMultiprocessor(&per_cu, (const void*)mega_fwd, NWAVES * 64, LDS_BYTES) != hipSuccess || per_cu < 1) { fprintf(stderr, "kernel_launch: occupancy query reports %d workgroups per CU\n", per_cu); }
        (void)hipGetLastError();
        grid = cus;
    }
    if (grid < 0) return;
    if (hipMemsetAsync((char*)d_ws + WS_CTL, 0, CTL_ZERO_BYTES, stream) != hipSuccess) { fprintf(stderr, "kernel_launch: memset failed\n"); return; }
    Args a{};
    for (int i = 0; i < 17; ++i) a.in[i] = (const float*)d_in[i];
    a.out = (float*)d_out; a.ws = (unsigned char*)d_ws;
#ifndef MK_SPLIT
    a.ph_lo = 0; a.ph_hi = N_PHASES;
    hipLaunchKernelGGL(mega_fwd, dim3(grid), dim3(NWAVES * 64), LDS_BYTES, stream, a);
#else
    for (int p = 0; p < N_PHASES; ++p) { a.ph_lo = p; a.ph_hi = p + 1; hipLaunchKernelGGL(mega_fwd, dim3(grid), dim3(NWAVES * 64), LDS_BYTES, stream, a); }
#endif
    const hipError_t le = hipPeekAtLastError();
    if (le != hipSuccess) fprintf(stderr, "kernel_launch: launch failed: %s\n", hipGetErrorName(le));
}
```

```cpp
#include <hip/hip_runtime.h>
#include <stdint.h>
#include <stdio.h>

constexpr int D = 4096, M = 32768, MH = 16384, DFF = 11008;
constexpr int AB_IN = 8224, C_IN = 5120;
constexpr float ALPHA = 1.41421356237309515f;
constexpr float LN_EPS = 1e-5f;
constexpr size_t MiB = 1u << 20;
constexpr size_t WS_CTL = 0, CTL_ZERO_BYTES = 3 * MiB;
constexpr size_t WS_STATS = 1 * MiB, WS_CS = 2 * MiB;
constexpr int CS13 = 0, BW13 = 22016, CS13_L1 = 44032, BW13_L1 = 66048, CSC = 88064, BWC = 93184, NYQ = 98304;
constexpr size_t WS_WIN = 3 * MiB, WS_WOUT = 68 * MiB, WS_CIN = 100 * MiB, WS_COUT = 140 * MiB, WS_DFTC = 172 * MiB, WS_DFTP = 173 * MiB, WS_DFTS = 189 * MiB;
constexpr size_t WS_W13 = 253 * MiB, WS_W2 = 425 * MiB, WS_XB = 511 * MiB, WS_ACT = 767 * MiB;
constexpr size_t WS_PROJ = WS_ACT, WS_UN = WS_ACT + 258 * MiB, WS_UCS = WS_ACT + 322 * MiB, WS_QK = WS_ACT + 450 * MiB,
                 WS_O = WS_ACT + 578 * MiB, WS_MIX = WS_ACT + 706 * MiB, WS_KT = WS_ACT + 962 * MiB, WS_PB = WS_ACT + 1026 * MiB, WS_EB = WS_ACT + 1042 * MiB, WS_END0 = WS_ACT + 1044 * MiB;
constexpr size_t WS_HID = WS_ACT;
constexpr size_t WS_W13_L1 = WS_ACT + 700 * MiB, WS_W2_L1 = WS_ACT + 872 * MiB;
constexpr size_t WS_CPROJ = WS_ACT, WS_ATTO = WS_ACT + 320 * MiB;
constexpr size_t WS_NEED = WS_END0;
constexpr int CW_BAR = 4096;
constexpr int NWAVES = 8;
constexpr int RING_OFF = 0, RING_BYTES = 131072;
constexpr int LDS_BYTES = 147456;
constexpr int LDSCTL_OFF = LDS_BYTES - 512, MISC_OFF = LDSCTL_OFF + 320;

#define GAS __attribute__((address_space(1)))
#define LAS __attribute__((address_space(3)))
typedef unsigned short bf16;
typedef unsigned v4u __attribute__((ext_vector_type(4)));
typedef unsigned v2u __attribute__((ext_vector_type(2)));
typedef float f32x4 __attribute__((ext_vector_type(4)));
typedef float f32x2 __attribute__((ext_vector_type(2)));
typedef short bf16x8 __attribute__((ext_vector_type(8)));
#define LDS_WAIT() asm volatile("s_waitcnt lgkmcnt(0)" ::: "memory")
#define VM_WAIT() asm volatile("s_waitcnt vmcnt(0)" ::: "memory")
__device__ __forceinline__ unsigned f2bf(float f) { unsigned u = __builtin_bit_cast(unsigned, f); return (u + 0x7fffu + ((u >> 16) & 1u)) >> 16; }
__device__ __forceinline__ float bf2f(unsigned b) { return __builtin_bit_cast(float, b << 16); }
typedef float f32x2_t __attribute__((ext_vector_type(2))); typedef __bf16 bf16x2_t __attribute__((ext_vector_type(2)));
__device__ __forceinline__ unsigned pk2(float lo, float hi) { f32x2_t v = {lo, hi}; bf16x2_t b = __builtin_convertvector(v, bf16x2_t); return __builtin_bit_cast(unsigned, b); }
template <int CTRL> __device__ __forceinline__ float dpp_add(float x) { const int y = __builtin_amdgcn_update_dpp(0, __builtin_bit_cast(int, x), CTRL, 0xf, 0xf, false); return x + __builtin_bit_cast(float, y); }
__device__ __forceinline__ float sum8(float v) { v = dpp_add<0xB1>(v); v = dpp_add<0x4E>(v); return dpp_add<0x141>(v); }
__device__ __forceinline__ float wave_sum(float v) { v = sum8(v); v = dpp_add<0x140>(v); v += __shfl_xor(v, 16); v += __shfl_xor(v, 32); return v; }
__device__ __forceinline__ float silu_f(float a) { return a * __builtin_amdgcn_rcpf(1.0f + __expf(-a)); }

namespace pg8 {
#define PG8_LAS __attribute__((address_space(3)))
typedef unsigned short bf16_t;
typedef short bf16x8 __attribute__((ext_vector_type(8)));
typedef float f32x4 __attribute__((ext_vector_type(4)));
typedef unsigned u32x4 __attribute__((ext_vector_type(4)));
constexpr int BM = 256, BK = 64, HALF = 128, HTB = HALF * BK * 2  , STAGE_BYTES = 8 * HTB, NXCD = 8, WGM = 4;

__host__ __device__ __forceinline__ int lds_byte(int r, int c) { const int st = (r >> 4) * 2 + (c >> 5), rr = r & 15, cc = c & 31, ob = rr * 64 + cc * 2; return st * 1024 + (ob ^ (((ob >> 9) & 1) << 5)); }
__host__ __device__ __forceinline__ void stage_rc(int b, int& R, int& C) { const int st = b / 1024, sb = b % 1024, swz = sb ^ (((sb >> 9) & 1) << 5); R = (st >> 1) * 16 + swz / 64; C = (st & 1) * 32 + (swz % 64) / 2; }
__host__ __device__ __forceinline__ int perm32(int rho) { const int n = rho >> 4, i = rho & 15; return 8 * (i >> 2) + 4 * n + (i & 3); }

struct Unit { int pm, pn; };
struct Gemm { const bf16_t* A; const bf16_t* Bt; int M, N, K; };

struct StaticOrder {
    int nM, nN, nwg, G, c;
    __host__ __device__ void init(int M, int N, int G_, int c_) { nM = M / BM; nN = N / BM; nwg = nM * nN; G = G_; c = c_; }
    __host__ __device__ bool next(int i, Unit& u) const {
        const long L = (long)i * G + c; if (L >= nwg) return false;
        int wgid = (int)L; { const int q = nwg / NXCD, r = nwg % NXCD, xcd = wgid % NXCD, off = wgid / NXCD; wgid = (xcd < r ? xcd * (q + 1) : r * (q + 1) + (xcd - r) * q) + off; }
        const int nig = WGM * nN, gid = wgid / nig, fm = gid * WGM, gsz = (nM - fm) < WGM ? (nM - fm) : WGM;
        u.pm = fm + ((wgid % nig) % gsz); u.pn = (wgid % nig) / gsz; return true;
    }
    __device__ __forceinline__ void a_ready(const Unit&) const {}
    __device__ __forceinline__ void done(const Unit&) const {}
};

__device__ __forceinline__ unsigned cvt_pk_bf16(float lo, float hi) { unsigned r; asm volatile("v_cvt_pk_bf16_f32 %0, %1, %2" : "=v"(r) : "v"(lo), "v"(hi)); return r; }
struct ReverseOrder : StaticOrder {
    __host__ __device__ bool next(int i, Unit& u) const { if (!StaticOrder::next(i, u)) return false; u.pm = nM - 1 - u.pm; return true; } };
struct FoldOrder : StaticOrder { int lgS;
    __host__ __device__ bool next(int i, Unit& u) const { if (!StaticOrder::next(i, u)) return false; const int S = 1 << lgS; if (((u.pn * BM) & (S - 1)) >= (S >> 1)) u.pm += 2; return true; } };
__device__ __forceinline__ u32x4 pack8(const f32x4& a, const f32x4& b) { u32x4 w; w.x = cvt_pk_bf16(a[0], a[1]); w.y = cvt_pk_bf16(a[2], a[3]); w.z = cvt_pk_bf16(b[0], b[1]); w.w = cvt_pk_bf16(b[2], b[3]); return w; }
struct EpiStoreBf {
    static constexpr bool PERM = true, AFTER_DRAIN = false;
    bf16_t* O; int ldc;
    __device__ __forceinline__ void operator()(const f32x4 (&acc)[2][2][4][2], const Unit& u, int wr, int wc, int fr, int fq) const {
        const int row0 = u.pm * BM + wr * 64 + fr, col0 = u.pn * BM + wc * 32 + 8 * fq;
#pragma unroll
        for (int ai = 0; ai < 2; ++ai)
#pragma unroll
            for (int m = 0; m < 4; ++m) { bf16_t* rowp = O + (size_t)(row0 + ai * HALF + m * 16) * ldc + col0;
#pragma unroll
                for (int bj = 0; bj < 2; ++bj) *(u32x4*)(rowp + bj * HALF) = pack8(acc[ai][bj][m][0], acc[ai][bj][m][1]); }
    }
};
struct EpiF1 {
    static constexpr bool PERM = true, AFTER_DRAIN = false;
    bf16_t* U; int lgS;
    __device__ __forceinline__ void operator()(const f32x4 (&acc)[2][2][4][2], const Unit& u, int wr, int wc, int fr, int fq) const {
        const int row0 = u.pm * BM + wr * 64 + fr, col0 = u.pn * BM + wc * 32 + 8 * fq, S = 1 << lgS;
#pragma unroll
        for (int ai = 0; ai < 2; ++ai)
#pragma unroll
            for (int m = 0; m < 4; ++m) { const int r = row0 + ai * HALF + m * 16;
#pragma unroll
                for (int bj = 0; bj < 2; ++bj) { const int c = col0 + bj * HALF, z = c >> lgS, k = c & (S - 1);
                    *(u32x4*)(U + ((size_t)z * 512 + (r & 511)) * S + k) = pack8(acc[ai][bj][m][0], acc[ai][bj][m][1]); } }
    }
};
struct EpiF2 {
    static constexpr bool PERM = true, AFTER_DRAIN = false;
    bf16_t* mix; int S; const float* nyq;
    __device__ __forceinline__ void operator()(const f32x4 (&acc)[2][2][4][2], const Unit& u, int wr, int wc, int fr, int fq) const {
        const int row0 = u.pm * BM + wr * 64 + fr, col0 = u.pn * BM + wc * 32 + 8 * fq;
        f32x4 ny[2][2];
#pragma unroll
        for (int bj = 0; bj < 2; ++bj)
#pragma unroll
            for (int n = 0; n < 2; ++n) ny[bj][n] = *(const f32x4*)(nyq + col0 + bj * HALF + 4 * n);
#pragma unroll
        for (int ai = 0; ai < 2; ++ai)
#pragma unroll
            for (int m = 0; m < 4; ++m) { const int r = row0 + ai * HALF + m * 16; const float sg = (r & 1) ? -1.0f : 1.0f;
#pragma unroll
                for (int bj = 0; bj < 2; ++bj) { const int c = col0 + bj * HALF, z = c >> 9, cp = c & 511, b = z >> 2, g = z & 3;
                    const u32x4 w = pack8(acc[ai][bj][m][0] + ny[bj][0] * sg, acc[ai][bj][m][1] + ny[bj][1] * sg);
                    *(u32x4*)(mix + ((size_t)b * S + r) * 4096 + g * 512 + cp) = w;
                    if (r != 0) { bf16_t* mr = mix + ((size_t)b * S + (S - r)) * 4096 + g * 512;
                        const int A = (504 - cp) & 511;
                        typedef unsigned u32x2 __attribute__((ext_vector_type(2)));
                        mr[A + 1] = (bf16_t)(w.w >> 16);
                        *(unsigned*)(mr + A + 2) = (w.w & 0xffffu) | (w.z & 0xffff0000u);
                        *(u32x2*)(mr + A + 4) = (u32x2){(w.z & 0xffffu) | (w.y & 0xffff0000u), (w.y & 0xffffu) | (w.x & 0xffff0000u)};
                        mr[(A + 8) & 511] = (bf16_t)(w.x & 0xffffu); } } }
    }
};
__device__ __forceinline__ void row_stats(const float* st, int row, float& mu, float& rstd) { const float s = st[2 * row], ss = st[2 * row + 1]; mu = s * (1.0f / 4096.0f); rstd = rsqrtf(fmaxf(ss * (1.0f / 4096.0f) - mu * mu, 0.f) + 1e-5f); }
template <bool LN_IN> struct EpiResid {
    static constexpr bool PERM = true, AFTER_DRAIN = false;
    const float* x0; const float* x1p; float* outf; const bf16_t* xres; bf16_t* xb; const float* st_in; const float* g_in; const float* b_in; float* st_out; float alpha;
    __device__ __forceinline__ void operator()(const f32x4 (&acc)[2][2][4][2], const Unit& u, int wr, int wc, int fr, int fq) const {
        const int row0 = u.pm * BM + wr * 64 + fr, col0 = u.pn * BM + wc * 32 + 8 * fq;
        const float* xin = (u.pm < 64) ? x0 : x1p;
        f32x4 gv[2][2], bv[2][2];
        if (LN_IN) {
#pragma unroll
            for (int bj = 0; bj < 2; ++bj)
#pragma unroll
                for (int n = 0; n < 2; ++n) { gv[bj][n] = *(const f32x4*)(g_in + col0 + bj * HALF + 4 * n); bv[bj][n] = *(const f32x4*)(b_in + col0 + bj * HALF + 4 * n); } }
#pragma unroll
        for (int ai = 0; ai < 2; ++ai)
#pragma unroll
            for (int mp = 0; mp < 2; ++mp) {
                f32x4 xv[2][2][2]; float mu[2] = {0.f, 0.f}, rstd[2] = {1.f, 1.f};
                u32x4 wraw[2][2]; ::f32x2 sraw[2];
#pragma unroll
                for (int mm = 0; mm < 2; ++mm) { const int row = row0 + ai * HALF + (2 * mp + mm) * 16; const size_t off = (size_t)row * 4096 + col0;
#pragma unroll
                    for (int bj = 0; bj < 2; ++bj) {
                        if (LN_IN) wraw[mm][bj] = *(const u32x4*)(xres + off + bj * HALF);
                        else { xv[mm][bj][0] = *(const f32x4*)(xin + off + bj * HALF); xv[mm][bj][1] = *(const f32x4*)(xin + off + bj * HALF + 4); } }
                    if (LN_IN) sraw[mm] = *(const ::f32x2*)(st_in + 2 * row); }
                asm volatile("" ::: "memory");
                if (LN_IN) {
#pragma unroll
                    for (int mm = 0; mm < 2; ++mm) {
#pragma unroll
                        for (int bj = 0; bj < 2; ++bj) { const u32x4 w = wraw[mm][bj];
                            xv[mm][bj][0] = (f32x4){__builtin_bit_cast(float, w.x << 16), __builtin_bit_cast(float, w.x & 0xffff0000u), __builtin_bit_cast(float, w.y << 16), __builtin_bit_cast(float, w.y & 0xffff0000u)};
                            xv[mm][bj][1] = (f32x4){__builtin_bit_cast(float, w.z << 16), __builtin_bit_cast(float, w.z & 0xffff0000u), __builtin_bit_cast(float, w.w << 16), __builtin_bit_cast(float, w.w & 0xffff0000u)}; }
                        const float m_ = sraw[mm].x * (1.0f / 4096.0f); mu[mm] = m_; rstd[mm] = rsqrtf(fmaxf(sraw[mm].y * (1.0f / 4096.0f) - m_ * m_, 0.f) + 1e-5f); } }
#pragma unroll
                for (int mm = 0; mm < 2; ++mm) { const int m = 2 * mp + mm, row = row0 + ai * HALF + m * 16; const size_t off = (size_t)row * 4096 + col0;
                    float rs = 0.f, rss = 0.f;
#pragma unroll
                    for (int bj = 0; bj < 2; ++bj) { f32x4 v[2];
#pragma unroll
                        for (int n = 0; n < 2; ++n) { f32x4 x = xv[mm][bj][n];
                            if (LN_IN) x = (x - mu[mm]) * rstd[mm] * gv[bj][n] + bv[bj][n];
                            v[n] = x * alpha + acc[ai][bj][m][n];
                            rs += (v[n][0] + v[n][1]) + (v[n][2] + v[n][3]); rss += (v[n][0] * v[n][0] + v[n][1] * v[n][1]) + (v[n][2] * v[n][2] + v[n][3] * v[n][3]); }
                        if (outf) { *(f32x4*)(outf + off + bj * HALF) = v[0]; *(f32x4*)(outf + off + bj * HALF + 4) = v[1]; }
                        if (xb) *(u32x4*)(xb + off + bj * HALF) = pack8(v[0], v[1]); }
                    if (st_out) { rs += __shfl_xor(rs, 16); rss += __shfl_xor(rss, 16); rs += __shfl_xor(rs, 32); rss += __shfl_xor(rss, 32);
                        if (fq == 0) { atomicAdd(st_out + 2 * row, rs); atomicAdd(st_out + 2 * row + 1, rss); } } }
            }
    }
};
struct EpiStoreBfFold {
    static constexpr bool PERM = true, AFTER_DRAIN = false;
    bf16_t* O; int ldc; const float* st; const float* cs; const float* bw;
    __device__ __forceinline__ void operator()(const f32x4 (&acc)[2][2][4][2], const Unit& u, int wr, int wc, int fr, int fq) const {
        const int row0 = u.pm * BM + wr * 64 + fr, col0 = u.pn * BM + wc * 32 + 8 * fq;
        f32x4 c4[2][2], b4[2][2];
#pragma unroll
        for (int bj = 0; bj < 2; ++bj)
#pragma unroll
            for (int n = 0; n < 2; ++n) { c4[bj][n] = *(const f32x4*)(cs + col0 + bj * HALF + 4 * n); b4[bj][n] = *(const f32x4*)(bw + col0 + bj * HALF + 4 * n); }
        float mus[2][4], rsd[2][4];
        { ::f32x2 raw[2][4];
#pragma unroll
        for (int ai = 0; ai < 2; ++ai)
#pragma unroll
            for (int m = 0; m < 4; ++m) raw[ai][m] = *(const ::f32x2*)(st + 2 * (row0 + ai * HALF + m * 16));
        asm volatile("" ::: "memory");
#pragma unroll
        for (int ai = 0; ai < 2; ++ai)
#pragma unroll
            for (int m = 0; m < 4; ++m) { const float mu = raw[ai][m].x * (1.0f / 4096.0f); mus[ai][m] = mu; rsd[ai][m] = rsqrtf(fmaxf(raw[ai][m].y * (1.0f / 4096.0f) - mu * mu, 0.f) + 1e-5f); } }
#pragma unroll
        for (int ai = 0; ai < 2; ++ai)
#pragma unroll
            for (int m = 0; m < 4; ++m) { const int row = row0 + ai * HALF + m * 16; const float mu = mus[ai][m], rstd = rsd[ai][m];
                bf16_t* rowp = O + (size_t)row * ldc + col0;
#pragma unroll
                for (int bj = 0; bj < 2; ++bj) { const f32x4 y0 = (acc[ai][bj][m][0] - c4[bj][0] * mu) * rstd + b4[bj][0], y1 = (acc[ai][bj][m][1] - c4[bj][1] * mu) * rstd + b4[bj][1];
                    *(u32x4*)(rowp + bj * HALF) = pack8(y0, y1); } }
    }
};
struct EpiSwiGLU {
    static constexpr bool PERM = true, AFTER_DRAIN = false;
    bf16_t* H; int ldh; const float* st; const float* cs; const float* bw;
    __device__ __forceinline__ void operator()(const f32x4 (&acc)[2][2][4][2], const Unit& u, int wr, int wc, int fr, int fq) const {
        const int row0 = u.pm * BM + wr * 64 + fr, col0 = u.pn * HALF + wc * 32 + 8 * fq, cb = u.pn * BM + wc * 32 + 8 * fq;
        f32x4 c4[2][2], b4[2][2];
#pragma unroll
        for (int bj = 0; bj < 2; ++bj)
#pragma unroll
            for (int n = 0; n < 2; ++n) { c4[bj][n] = *(const f32x4*)(cs + cb + bj * HALF + 4 * n); b4[bj][n] = *(const f32x4*)(bw + cb + bj * HALF + 4 * n); }
        float mus[2][4], rsd[2][4];
        { ::f32x2 raw[2][4];
#pragma unroll
        for (int ai = 0; ai < 2; ++ai)
#pragma unroll
            for (int m = 0; m < 4; ++m) raw[ai][m] = *(const ::f32x2*)(st + 2 * (row0 + ai * HALF + m * 16));
        asm volatile("" ::: "memory");
#pragma unroll
        for (int ai = 0; ai < 2; ++ai)
#pragma unroll
            for (int m = 0; m < 4; ++m) { const float mu = raw[ai][m].x * (1.0f / 4096.0f); mus[ai][m] = mu; rsd[ai][m] = rsqrtf(fmaxf(raw[ai][m].y * (1.0f / 4096.0f) - mu * mu, 0.f) + 1e-5f); } }
#pragma unroll
        for (int ai = 0; ai < 2; ++ai)
#pragma unroll
            for (int m = 0; m < 4; ++m) { const int row = row0 + ai * HALF + m * 16; const float mu = mus[ai][m], rstd = rsd[ai][m];
                f32x4 h[2];
                f32x4 a1[2], a3[2], e[2];
#pragma unroll
                for (int n = 0; n < 2; ++n) { a1[n] = (acc[ai][0][m][n] - c4[0][n] * mu) * rstd + b4[0][n]; a3[n] = (acc[ai][1][m][n] - c4[1][n] * mu) * rstd + b4[1][n]; e[n] = a1[n] * -1.4426950408889634f; }
#pragma unroll
                for (int n = 0; n < 2; ++n)
#pragma unroll
                    for (int j = 0; j < 4; ++j) e[n][j] = __builtin_amdgcn_exp2f(e[n][j]);
                asm volatile("" : "+v"(e[0]), "+v"(e[1]));
                e[0] = e[0] + 1.0f; e[1] = e[1] + 1.0f;
#pragma unroll
                for (int n = 0; n < 2; ++n)
#pragma unroll
                    for (int j = 0; j < 4; ++j) e[n][j] = __builtin_amdgcn_rcpf(e[n][j]);
                asm volatile("" : "+v"(e[0]), "+v"(e[1]));
                h[0] = a1[0] * a3[0] * e[0]; h[1] = a1[1] * a3[1] * e[1];
                *(u32x4*)(H + (size_t)row * ldh + col0) = pack8(h[0], h[1]); }
    }
};
template <class Epi, class Sched, bool ALIGN_EPI = false, bool SP2 = false>
__device__ __forceinline__ void gemm_phase(PG8_LAS unsigned char* lds, const Gemm g, const Sched& S, const Epi& E) {
    int tid_ = threadIdx.x; asm volatile("" : "+v"(tid_));
    const int tid = tid_, wid = __builtin_amdgcn_readfirstlane(tid >> 6), lane = tid & 63, wr = wid >> 2, wc = wid & 3, fr = lane & 15, fq = lane >> 4;
    const int K = g.K, nt = K / BK;
    unsigned voffA[2], voffB[2];
#pragma unroll
    for (int i = 0; i < 2; ++i) { int R, C; stage_rc(tid * 16 + i * 8192, R, C); const int Rb = Epi::PERM ? ((R & ~31) + perm32(R & 31)) : R;
        voffA[i] = (unsigned)(R * K + C) * 2u; voffB[i] = (unsigned)(Rb * K + C) * 2u; }
    const size_t kstep = (size_t)(BK * 2);
    const size_t hstep = (size_t)HALF * K * 2;
    const size_t tstep = 2 * hstep;
    const unsigned ldsw = (unsigned)wid * 1024u;
    const int aoff = lds_byte(wr * 64 + fr, fq * 8), boff = lds_byte(wc * 32 + fr, fq * 8);
#define PG8_SA(b, h) (((b) * 2 + (h)) * HTB)
#define PG8_SB(b, h) ((4 + (b) * 2 + (h)) * HTB)
#define PG8_STAGE(bufoff, gbase, voff) do { _Pragma("unroll") for (int _i = 0; _i < 2; ++_i) \
        __builtin_amdgcn_global_load_lds((const unsigned*)((const char*)(gbase) + (voff)[_i]), (PG8_LAS unsigned*)(lds + (bufoff) + ldsw + _i * 8192), 16, 0, 0); } while (0)
#define PG8_LDA(dst, b, h) do { _Pragma("unroll") for (int m = 0; m < 4; ++m) _Pragma("unroll") for (int k = 0; k < 2; ++k) dst[m][k] = *(const PG8_LAS bf16x8*)(lds + PG8_SA(b, h) + aoff + m * 2048 + k * 1024); } while (0)
#define PG8_LDB(dst, b, h) do { _Pragma("unroll") for (int n = 0; n < 2; ++n) _Pragma("unroll") for (int k = 0; k < 2; ++k) dst[n][k] = *(const PG8_LAS bf16x8*)(lds + PG8_SB(b, h) + boff + n * 2048 + k * 1024); } while (0)
#define PG8_MMA(ai, bj, At, Bt) do { __builtin_amdgcn_s_setprio(1); _Pragma("unroll") for (int m = 0; m < 4; ++m) _Pragma("unroll") for (int n = 0; n < 2; ++n) _Pragma("unroll") for (int k = 0; k < 2; ++k) \
        acc[ai][bj][m][n] = __builtin_amdgcn_mfma_f32_16x16x32_bf16(Bt[n][k], At[m][k], acc[ai][bj][m][n], 0, 0, 0); __builtin_amdgcn_s_setprio(0); } while (0)
#define PG8_WAIT_V(n) asm volatile("s_waitcnt vmcnt(" #n ")" ::: "memory")
#define PG8_WAIT_L(n) asm volatile("s_waitcnt lgkmcnt(" #n ")" ::: "memory")
#define PG8_BAR __builtin_amdgcn_s_barrier()
#define PG8_SCHED __builtin_amdgcn_sched_barrier(0)
    Unit cur, nxt; int ui = 0;
    if (!S.next(0, cur)) return;
    f32x4 acc[2][2][4][2];
#pragma unroll
    for (int a = 0; a < 2; ++a)
#pragma unroll
        for (int b = 0; b < 2; ++b)
#pragma unroll
            for (int m = 0; m < 4; ++m)
#pragma unroll
                for (int n = 0; n < 2; ++n) acc[a][b][m][n] = (f32x4){0.f, 0.f, 0.f, 0.f};
    bf16x8 At[4][2], B0[2][2], B1[2][2];
    const char* cA = (const char*)g.A + (size_t)cur.pm * tstep; const char* cB = (const char*)g.Bt + (size_t)cur.pn * tstep;
    S.a_ready(cur);
    if constexpr (SP2) {
        PG8_STAGE(PG8_SB(0, 0), cB, voffB); PG8_STAGE(PG8_SB(0, 1), cB + hstep, voffB); PG8_STAGE(PG8_SA(0, 0), cA, voffA); PG8_STAGE(PG8_SA(0, 1), cA + hstep, voffA);
        if (wr == 1) PG8_BAR;
        PG8_WAIT_V(2); PG8_BAR;
        PG8_STAGE(PG8_SB(1, 0), cB + kstep, voffB); PG8_STAGE(PG8_SA(1, 0), cA + kstep, voffA); PG8_STAGE(PG8_SB(1, 1), cB + hstep + kstep, voffB);
        PG8_WAIT_V(6); PG8_BAR;
    } else {
        PG8_STAGE(PG8_SB(0, 0), cB, voffB); PG8_STAGE(PG8_SA(0, 0), cA, voffA); PG8_STAGE(PG8_SB(0, 1), cB + hstep, voffB); PG8_STAGE(PG8_SA(0, 1), cA + hstep, voffA);
        if (wr == 1) PG8_BAR;
        PG8_WAIT_V(4); PG8_BAR;
        PG8_STAGE(PG8_SB(1, 0), cB + kstep, voffB); PG8_STAGE(PG8_SA(1, 0), cA + kstep, voffA); PG8_STAGE(PG8_SB(1, 1), cB + hstep + kstep, voffB);
        PG8_WAIT_V(6); PG8_BAR;
    }
    for (;;) {
        const bool has_next = S.next(ui + 1, nxt);
        const char* nA = has_next ? (const char*)g.A + (size_t)nxt.pm * tstep : cA; const char* nB = has_next ? (const char*)g.Bt + (size_t)nxt.pn * tstep : cB;
        for (int t = 0; t < nt; t += 2) {
            const bool last = (t == nt - 2);
            const char* a1 = cA + (size_t)(t + 1) * kstep;
            const char* a2 = last ? nA : cA + (size_t)(t + 2) * kstep; const char* b2 = last ? nB : cB + (size_t)(t + 2) * kstep;
            const char* a3 = a2 + kstep; const char* b3 = b2 + kstep;
            if (last && has_next) S.a_ready(nxt);
            if constexpr (SP2) {
            PG8_LDB(B0, 0, 0); PG8_LDB(B1, 0, 1); PG8_SCHED; PG8_LDA(At, 0, 0); PG8_STAGE(PG8_SA(1, 1), a1 + hstep, voffA);
            PG8_WAIT_V(8); PG8_WAIT_L(0); PG8_BAR; PG8_MMA(0, 0, At, B0); PG8_MMA(0, 1, At, B1); PG8_BAR; PG8_SCHED;
            PG8_LDA(At, 0, 1); PG8_STAGE(PG8_SB(0, 0), b2, voffB); PG8_STAGE(PG8_SB(0, 1), b2 + hstep, voffB); PG8_STAGE(PG8_SA(0, 0), a2, voffA);
            PG8_WAIT_V(8); PG8_WAIT_L(0); PG8_BAR; PG8_MMA(1, 0, At, B0); PG8_MMA(1, 1, At, B1); PG8_BAR; PG8_SCHED;
            PG8_LDB(B0, 1, 0); PG8_LDB(B1, 1, 1); PG8_SCHED; PG8_LDA(At, 1, 0); PG8_STAGE(PG8_SA(0, 1), a2 + hstep, voffA);
            PG8_WAIT_V(8); PG8_WAIT_L(0); PG8_BAR; PG8_MMA(0, 0, At, B0); PG8_MMA(0, 1, At, B1); PG8_BAR; PG8_SCHED;
            PG8_LDA(At, 1, 1); PG8_STAGE(PG8_SB(1, 0), b3, voffB); PG8_STAGE(PG8_SB(1, 1), b3 + hstep, voffB); PG8_STAGE(PG8_SA(1, 0), a3, voffA);
            PG8_WAIT_V(8); PG8_WAIT_L(0); PG8_BAR; PG8_MMA(1, 0, At, B0); PG8_MMA(1, 1, At, B1); PG8_BAR; PG8_SCHED;
            } else {
            PG8_LDB(B0, 0, 0); PG8_SCHED; PG8_LDA(At, 0, 0); PG8_STAGE(PG8_SA(1, 1), a1 + hstep, voffA);
            PG8_WAIT_L(8); PG8_BAR; PG8_WAIT_L(0); PG8_MMA(0, 0, At, B0); PG8_BAR; PG8_SCHED;
            PG8_LDB(B1, 0, 1); PG8_STAGE(PG8_SB(0, 0), b2, voffB);
            PG8_BAR; PG8_WAIT_L(0); PG8_MMA(0, 1, At, B1); PG8_BAR;
            PG8_LDA(At, 0, 1); PG8_STAGE(PG8_SA(0, 0), a2, voffA);
            PG8_BAR; PG8_WAIT_L(0); PG8_MMA(1, 0, At, B0); PG8_BAR; PG8_SCHED;
            PG8_STAGE(PG8_SB(0, 1), b2 + hstep, voffB);
            PG8_WAIT_V(6); PG8_BAR; PG8_MMA(1, 1, At, B1); PG8_BAR;
            PG8_LDB(B0, 1, 0); PG8_SCHED; PG8_LDA(At, 1, 0); PG8_STAGE(PG8_SA(0, 1), a2 + hstep, voffA);
            PG8_WAIT_L(8); PG8_BAR; PG8_WAIT_L(0); PG8_MMA(0, 0, At, B0); PG8_BAR; PG8_SCHED;
            PG8_LDB(B1, 1, 1); PG8_STAGE(PG8_SB(1, 0), b3, voffB);
            PG8_BAR; PG8_WAIT_L(0); PG8_MMA(0, 1, At, B1); PG8_BAR;
            PG8_LDA(At, 1, 1); PG8_STAGE(PG8_SA(1, 0), a3, voffA);
            PG8_BAR; PG8_WAIT_L(0); PG8_MMA(1, 0, At, B0); PG8_BAR; PG8_SCHED;
            PG8_STAGE(PG8_SB(1, 1), b3 + hstep, voffB);
            PG8_WAIT_V(6); PG8_BAR; PG8_MMA(1, 1, At, B1); PG8_BAR;
            }
        }
        if constexpr (ALIGN_EPI) { if (wr == 0) PG8_BAR; }
        if constexpr (!Epi::AFTER_DRAIN) { E(acc, cur, wr, wc, fr, fq); S.done(cur); }
        if (!has_next) break;
#pragma unroll
        for (int a = 0; a < 2; ++a)
#pragma unroll
            for (int b = 0; b < 2; ++b)
#pragma unroll
                for (int m = 0; m < 4; ++m)
#pragma unroll
                    for (int n = 0; n < 2; ++n) acc[a][b][m][n] = (f32x4){0.f, 0.f, 0.f, 0.f};
        cur = nxt; cA = nA; cB = nB; ++ui;
        if constexpr (ALIGN_EPI) { if (wr == 1) PG8_BAR; }
    }
    PG8_WAIT_V(0);
    if constexpr (!ALIGN_EPI) { if (wr == 0) PG8_BAR; }
    PG8_BAR;
    if constexpr (Epi::AFTER_DRAIN) { E.fused(acc, cur, wr, wc, fr, fq, lds, wid, lane); S.done(cur); }
#undef PG8_SA
#undef PG8_SB
#undef PG8_STAGE
#undef PG8_LDA
#undef PG8_LDB
#undef PG8_MMA
#undef PG8_WAIT_V
#undef PG8_WAIT_L
#undef PG8_BAR
#undef PG8_SCHED
}
}
#define XB_TMO      128
#define XB_XCNT(j)  (256  + 64 * (j))
#define XB_XSUB(j)  (1280 + 64 * (j))
#define XB_XGEN(j)  (2304 + 64 * (j))
#define XB_TOP      3328
#define XB_TOPGEN   3392
#define XCD_BAR_WORDS 3456
#define XB_SPIN_CAP (1u << 18)

__device__ __forceinline__ unsigned xb_ld(unsigned* p)              { return __hip_atomic_load(p, __ATOMIC_RELAXED, __HIP_MEMORY_SCOPE_AGENT); }
__device__ __forceinline__ unsigned xb_add(unsigned* p, unsigned v) { return __hip_atomic_fetch_add(p, v, __ATOMIC_RELAXED, __HIP_MEMORY_SCOPE_AGENT); }
__device__ __forceinline__ unsigned xb_xcc_id() { return (unsigned)__builtin_amdgcn_s_getreg((3 << 11) | 20) & 0xFu; }
#define XB_SPIN(cond, bar) do { unsigned _sp = 0; while (cond) { __builtin_amdgcn_s_sleep(1); \
    if ((++_sp & 255u) == 0u) { if (xb_ld(&(bar)[XB_TMO])) break; if (_sp > XB_SPIN_CAP) { atomicAdd(&(bar)[XB_TMO], 1u); break; } } } } while (0)

struct XcdBarrier {
    unsigned* bar; unsigned x;
    volatile LAS unsigned* st;
};

__device__ __forceinline__ XcdBarrier xcd_barrier_post(unsigned* bar, volatile LAS unsigned* st) {
    XcdBarrier b; b.bar = bar; b.x = xb_xcc_id(); b.st = st;
    if (threadIdx.x == 0) (void)xb_add(&bar[XB_XCNT(b.x)], 1u);
    return b;
}
__device__ __forceinline__ void xcd_barrier_complete(unsigned* bar, unsigned x, unsigned& nloc, unsigned& nx) {
    const unsigned G = gridDim.x * gridDim.y * gridDim.z;
    unsigned sum, cnt, mine, sp = 0u;
    for (;;) {
        sum = 0u; cnt = 0u; mine = 0u;
#pragma unroll
        for (unsigned j = 0; j < 16; ++j) { const unsigned c = xb_ld(&bar[XB_XCNT(j)]); sum += c; cnt += (c > 0u) ? 1u : 0u; mine = (j == x) ? c : mine; }
        if (sum == G) break;
        __builtin_amdgcn_s_sleep(1);
        if ((++sp & 255u) == 0u) { if (xb_ld(&bar[XB_TMO])) break; if (sp > XB_SPIN_CAP) { atomicAdd(&bar[XB_TMO], 1u); break; } }
    }
    nloc = mine > 0u ? mine : 1u; nx = cnt > 0u ? cnt : 1u;
}

__device__ __forceinline__ void xcd_barrier(const XcdBarrier& b) {
    asm volatile("s_waitcnt vmcnt(0)" ::: "memory");
    __syncthreads();
    if (threadIdx.x == 0) {
        unsigned* bar = b.bar;
        __builtin_amdgcn_s_waitcnt(0);
        unsigned nloc = b.st[0], nx = b.st[1];
        if (nloc == 0u) { xcd_barrier_complete(bar, b.x, nloc, nx); b.st[0] = nloc; b.st[1] = nx; }
        const unsigned old = xb_add(&bar[XB_XSUB(b.x)], 1u);
        const unsigned gen = old / nloc;
        if (old + 1u == (gen + 1u) * nloc) {
            __builtin_amdgcn_fence(__ATOMIC_RELEASE, "agent");
            asm volatile("s_waitcnt vmcnt(0)" ::: "memory");
            const unsigned og = xb_add(&bar[XB_TOP], 1u);
            const unsigned tg = og / nx;
            if (og + 1u == (tg + 1u) * nx) xb_add(&bar[XB_TOPGEN], 1u);
            else XB_SPIN(xb_ld(&bar[XB_TOPGEN]) == tg, bar);
            __builtin_amdgcn_fence(__ATOMIC_ACQUIRE, "agent");
            xb_add(&bar[XB_XGEN(b.x)], 1u);
            asm volatile("s_waitcnt vmcnt(0)" ::: "memory");
        } else {
            XB_SPIN(xb_ld(&bar[XB_XGEN(b.x)]) == gen, bar);
            __builtin_amdgcn_fence(__ATOMIC_ACQUIRE, "agent");
            asm volatile("s_waitcnt vmcnt(0)" ::: "memory");
        }
    }
    __syncthreads();
}
#define OPAQUE(v) asm volatile("" : "+v"(v))
struct Frame {
    LAS unsigned char* lds;
    volatile LAS unsigned* MISC;
    unsigned* ctl;
    int tid, lane, wave, G;
    int gw, NGW;
};
__device__ __forceinline__ void frame_refresh(Frame& F) { int t = threadIdx.x; OPAQUE(t); F.tid = t; F.lane = t & 63; }

template <bool FOLD>
__device__ __forceinline__ void p0_process_item(int K, int N, bf16* WT, int G, int which, LAS float* scr, int item, int lane, f32x4 g0, f32x4 g1, f32x4 b0, f32x4 b1, float* cs, float* bw) {
    const int nblk = N / 32, kb = item / nblk, nb = item % nblk, k0 = 64 * kb, n0 = 32 * nb;
    const int c = lane & 7;
    float psA[4], pbA[4]; int rA[4];
#pragma unroll
    for (int j = 0; j < 4; ++j) { const int n = (lane >> 3) + 8 * j; const LAS float* s = scr + (8 * c) * 33 + n;
        float w8[8];
#pragma unroll
        for (int i = 0; i < 8; ++i) w8[i] = s[i * 33];
        float pb = 0.f;
        if (FOLD) {
#pragma unroll
            for (int i = 0; i < 8; ++i) { const float gg = (i < 4) ? g0[i & 3] : g1[i & 3], bb = (i < 4) ? b0[i & 3] : b1[i & 3]; pb += bb * w8[i]; w8[i] *= gg; } }
        v4u o; o.x = pk2(w8[0], w8[1]); o.y = pk2(w8[2], w8[3]); o.z = pk2(w8[4], w8[5]); o.w = pk2(w8[6], w8[7]);
        const int col = n0 + n; const int r = (G == 0) ? col : ((col / G) * 2 * G + which * G + col % G);
        *(GAS v4u*)(WT + (size_t)r * K + k0 + 8 * c) = o;
        if (FOLD) { float ps = 0.f;
#pragma unroll
            for (int i = 0; i < 4; ++i) ps += bf2f(o[i] & 0xffffu) + bf2f(o[i] >> 16);
            psA[j] = sum8(ps); pbA[j] = sum8(pb); rA[j] = r; } }
    if (FOLD) { const int jj = c & 3; const bool isb = (c & 4) != 0;
        const float vs = jj == 0 ? psA[0] : jj == 1 ? psA[1] : jj == 2 ? psA[2] : psA[3], vb = jj == 0 ? pbA[0] : jj == 1 ? pbA[1] : jj == 2 ? pbA[2] : pbA[3];
        const int rr = jj == 0 ? rA[0] : jj == 1 ? rA[1] : jj == 2 ? rA[2] : rA[3];
        atomicAdd((isb ? bw : cs) + rr, isb ? vb : vs); }
}
template <bool FOLD>
__device__ __forceinline__ void cvt_weight_impl(Frame& F, const float* W, int K, int N, bf16* WT, int G, int which, const float* gv, const float* bv, float* cs, float* bw) {
    frame_refresh(F);
    LAS float* scr = (LAS float*)(F.lds + RING_OFF + F.wave * 16384);
    const int nitems = (K / 64) * (N / 32), nblk = N / 32, lane = F.lane;
    float r[32];
    int it = F.gw;
    if (it >= nitems) return;
    { const int kb = it / nblk, nb = it % nblk; const float* src = W + (size_t)(64 * kb + (lane >> 5)) * N + 32 * nb + (lane & 31);
#pragma unroll
        for (int i = 0; i < 32; ++i) r[i] = __builtin_nontemporal_load(src + (size_t)(2 * i) * N);
#pragma unroll
        for (int i = 0; i < 32; ++i) scr[(2 * i + (lane >> 5)) * 33 + (lane & 31)] = r[i]; }
#pragma unroll 1
    for (; it < nitems; it += F.NGW) {
        const int nx = (it + F.NGW < nitems) ? it + F.NGW : it;
        f32x4 g0 = {0.f, 0.f, 0.f, 0.f}, g1 = g0, b0 = g0, b1 = g0;
        if (FOLD) { const int kq = 64 * (it / nblk) + 8 * (lane & 7); g0 = *(const f32x4*)(gv + kq); g1 = *(const f32x4*)(gv + kq + 4); b0 = *(const f32x4*)(bv + kq); b1 = *(const f32x4*)(bv + kq + 4); asm volatile("" ::: "memory"); }
        { const int kb = nx / nblk, nb = nx % nblk; const float* src = W + (size_t)(64 * kb + (lane >> 5)) * N + 32 * nb + (lane & 31);
#pragma unroll
            for (int i = 0; i < 32; ++i) r[i] = __builtin_nontemporal_load(src + (size_t)(2 * i) * N); }
        LDS_WAIT(); asm volatile("" ::: "memory");
        p0_process_item<FOLD>(K, N, WT, G, which, scr, it, lane, g0, g1, b0, b1, cs, bw);
        LDS_WAIT(); asm volatile("" ::: "memory");
#pragma unroll
        for (int i = 0; i < 32; ++i) scr[(2 * i + (lane >> 5)) * 33 + (lane & 31)] = r[i];
    }
}
__device__ __forceinline__ void cvt_weight(Frame& F, const float* W, int K, int N, bf16* WT, int G, int which) { cvt_weight_impl<false>(F, W, K, N, WT, G, which, nullptr, nullptr, nullptr, nullptr); }
__device__ __forceinline__ void cvt_weight_fold(Frame& F, const float* W, int K, int N, bf16* WT, int G, int which, const float* gv, const float* bv, float* cs, float* bw) { cvt_weight_impl<true>(F, W, K, N, WT, G, which, gv, bv, cs, bw); }
__device__ __forceinline__ void cvt_rows_bf16(Frame& F, const float* x, bf16* y, size_t n8) {
    frame_refresh(F);
    for (size_t i = (size_t)blockIdx.x * 512 + F.tid; i < n8; i += (size_t)F.G * 512) {
        const f32x4 a = __builtin_nontemporal_load((const f32x4*)(x + i * 8)), b = __builtin_nontemporal_load((const f32x4*)(x + i * 8 + 4));
        v4u o; o.x = pk2(a[0], a[1]); o.y = pk2(a[2], a[3]); o.z = pk2(b[0], b[1]); o.w = pk2(b[2], b[3]);
        *(v4u*)(y + i * 8) = o;
    }
}
__device__ __forceinline__ void gen_dftc(Frame& F, bf16* Dc) {
    frame_refresh(F);
    for (int i = blockIdx.x * 512 + F.tid; i < 1024 * 512; i += F.G * 512) {
        const int r = i >> 9, c = i & 511, rr = r & 511; const int idx = (rr * c) & 511;
        float s, co; sincospif(2.0f * (float)idx / 512.0f, &s, &co);
        Dc[i] = (bf16)f2bf((r < 512 ? co : s) * 0.04419417382415922f);
    }
}
__device__ __forceinline__ void gen_dfts(Frame& F, bf16* Ds, int lgS) {
    frame_refresh(F);
    const int S = 1 << lgS, H = S >> 1; const float sc = 1.0f / sqrtf((float)S);
    for (size_t i = (size_t)blockIdx.x * 512 + F.tid; i < ((size_t)1 << (2 * lgS - 1)); i += (size_t)F.G * 512) {
        const int sp = (int)(i >> lgS), k = (int)(i & (size_t)(S - 1)), r = k & (H - 1); const int idx = (int)(((long)sp * r) & (S - 1));
        float sn, co; sincospif(2.0f * (float)idx / (float)S, &sn, &co);
        Ds[i] = (bf16)f2bf(k < H ? co * sc : (k == H ? 0.f : -sn * sc));
    }
}

__device__ __forceinline__ void headnorm_phase(Frame& F, const bf16* O, const bf16* proj, const float* hg, bf16* mix) {
    frame_refresh(F);
    const int h = F.gw & 3, lane = F.lane;
    int t = F.gw;
    if (t >= MH * 4) return;
    const f32x4 g0 = *(const f32x4*)(hg + h * 512 + lane * 8), g1 = *(const f32x4*)(hg + h * 512 + lane * 8 + 4);
    v4u nof, nob, nrr;
    { const int row = t >> 2; nof = *(const v4u*)(O + (size_t)row * 2048 + h * 512 + lane * 8); nob = *(const v4u*)(O + (size_t)MH * 2048 + (size_t)row * 2048 + h * 512 + lane * 8);
      nrr = *(const v4u*)(proj + (size_t)row * 8192 + 6144 + h * 512 + lane * 8); }
#pragma unroll 1
    for (; t < MH * 4; t += F.NGW) { const int row = t >> 2;
        const v4u of = nof, ob = nob, rr = nrr;
        { const int rn = ((t + F.NGW < MH * 4) ? t + F.NGW : t) >> 2;
          nof = *(const v4u*)(O + (size_t)rn * 2048 + h * 512 + lane * 8); nob = *(const v4u*)(O + (size_t)MH * 2048 + (size_t)rn * 2048 + h * 512 + lane * 8);
          nrr = *(const v4u*)(proj + (size_t)rn * 8192 + 6144 + h * 512 + lane * 8); }
        float v[8];
#pragma unroll
        for (int j = 0; j < 4; ++j) { v[2 * j] = bf2f(of[j] & 0xffffu) + bf2f(ob[j] & 0xffffu); v[2 * j + 1] = bf2f(of[j] >> 16) + bf2f(ob[j] >> 16); }
        float s = 0.f;
#pragma unroll
        for (int j = 0; j < 8; ++j) s += v[j];
        const float mean = wave_sum(s) * (1.0f / 512.0f); float q = 0.f;
#pragma unroll
        for (int j = 0; j < 8; ++j) { v[j] -= mean; q += v[j] * v[j]; }
        const float rstd = rsqrtf(wave_sum(q) * (1.0f / 512.0f) + LN_EPS);
        float o[8];
#pragma unroll
        for (int j = 0; j < 8; ++j) { const float r = bf2f((j & 1) ? (rr[j >> 1] >> 16) : (rr[j >> 1] & 0xffffu)); const float gv = (j < 4) ? g0[j & 3] : g1[j & 3]; o[j] = v[j] * rstd * gv * silu_f(r); }
        v4u w; w.x = pk2(o[0], o[1]); w.y = pk2(o[2], o[3]); w.z = pk2(o[4], o[5]); w.w = pk2(o[6], o[7]);
        *(v4u*)(mix + (size_t)row * D + 2048 + h * 512 + lane * 8) = w; }
}
__device__ __forceinline__ void f2_mid_row(Frame& F, const bf16* B2, const float* nyq, bf16* mix, int S, int nz) {
    frame_refresh(F);
    const float isq = rsqrtf((float)S);
    for (int t = F.gw; t < nz * 512; t += F.NGW) { const int z = t >> 9, cp = t & 511, b = z >> 2, g = z & 3;
        const bf16* rp = B2 + (size_t)t * S + F.lane * 8; float acc = 0.f;
        const int nk = S >> 10;
        v4u wv[4]; const float ny = nyq[t];
#pragma unroll
        for (int i = 0; i < 4; ++i) { wv[i] = (v4u){0u, 0u, 0u, 0u}; if (i < nk) wv[i] = *(const v4u*)(rp + i * 512); }
#pragma unroll
        for (int i = 0; i < 4; ++i) { const v4u w = wv[i];
            acc += (bf2f(w.x & 0xffffu) - bf2f(w.x >> 16)) + (bf2f(w.y & 0xffffu) - bf2f(w.y >> 16)) + (bf2f(w.z & 0xffffu) - bf2f(w.z >> 16)) + (bf2f(w.w & 0xffffu) - bf2f(w.w >> 16)); }
        acc = wave_sum(acc);
        if (F.lane == 0) mix[((size_t)b * S + (S >> 1)) * D + g * 512 + cp] = (bf16)f2bf(acc * isq + ny); }
}
__device__ __forceinline__ void ln_phase(Frame& F, const float* xin, float* x, const float* g, const float* bta, bf16* xb) {
    frame_refresh(F);
    for (int row = F.gw; row < M; row += F.NGW) { const int lane = F.lane;
        float* xr = x + (size_t)row * D; const float* xi = xin + (size_t)row * D;
        f32x4 v[16]; float s = 0.f;
#pragma unroll
        for (int j = 0; j < 16; ++j) { v[j] = __builtin_nontemporal_load((const f32x4*)(xi + j * 256 + lane * 4)); s += (v[j][0] + v[j][1]) + (v[j][2] + v[j][3]); }
        const float mean = wave_sum(s) * (1.0f / D); float q = 0.f;
#pragma unroll
        for (int j = 0; j < 16; ++j) { v[j] = v[j] - mean; q += (v[j][0] * v[j][0] + v[j][1] * v[j][1]) + (v[j][2] * v[j][2] + v[j][3] * v[j][3]); }
        const float rstd = rsqrtf(wave_sum(q) * (1.0f / D) + LN_EPS);
#pragma unroll
        for (int j = 0; j < 16; ++j) { const int c = j * 256 + lane * 4; const f32x4 gg = *(const f32x4*)(g + c), bb = *(const f32x4*)(bta + c);
            const f32x4 o = v[j] * rstd * gg + bb; __builtin_nontemporal_store(o, (f32x4*)(xr + c));
            if (xb) { v2u w; w.x = pk2(o[0], o[1]); w.y = pk2(o[2], o[3]); *(v2u*)(xb + (size_t)row * D + c) = w; } } }
}
__device__ __forceinline__ int t5_bucket(int rel) {
    const int n = rel < 0 ? -rel : rel; int b;
    if (n < 8) b = n; else if (n < 12) b = 8; else if (n < 16) b = 9; else if (n < 23) b = 10; else if (n < 32) b = 11; else if (n < 46) b = 12; else if (n < 64) b = 13; else if (n < 91) b = 14; else b = 15;
    return b + (rel > 0 ? 16 : 0);
}
typedef float f32x16 __attribute__((ext_vector_type(16)));
#define MFMA32(a, b, c) __builtin_amdgcn_mfma_f32_32x32x16_bf16((a), (b), (c), 0, 0, 0)
__device__ __forceinline__ int crow(int r, int hh) { return (r & 3) + 8 * (r >> 2) + 4 * hh; }
__device__ __forceinline__ void p2_phase(Frame& F, const bf16* xbh, const bf16* Wg, const float* w2, const float* gb, const bf16* proj, const float* fg, bf16* un,
                                         bf16* QK, bf16* KT, bf16* PB, float* EB, const bf16* Dc, float* nyq, int S) {
    frame_refresh(F);
    LAS float* lrp = (LAS float*)(F.lds + RING_OFF);
    for (int cu = blockIdx.x; cu < MH / 64; cu += F.G) {
        const int row0 = cu * 64;
        { const int rt = F.wave & 3, kh = F.wave >> 2, fr = F.lane & 15, fq = F.lane >> 4;
          const bf16* ap = xbh + (size_t)(row0 + rt * 16 + fr) * D + kh * 2048 + 8 * fq;
          const bf16* bp0 = Wg + (size_t)fr * D + kh * 2048 + 8 * fq; const bf16* bp1 = bp0 + (size_t)16 * D;
          f32x4 a0 = (f32x4){0.f, 0.f, 0.f, 0.f}, a1 = a0;
#pragma unroll 1
          for (int k8 = 0; k8 < 8; ++k8) { bf16x8 av[8], b0[8], b1[8];
#pragma unroll
              for (int ks = 0; ks < 8; ++ks) { av[ks] = *(const bf16x8*)(ap + (k8 * 8 + ks) * 32); b0[ks] = *(const bf16x8*)(bp0 + (k8 * 8 + ks) * 32); b1[ks] = *(const bf16x8*)(bp1 + (k8 * 8 + ks) * 32); }
#pragma unroll
              for (int ks = 0; ks < 8; ++ks) { a0 = __builtin_amdgcn_mfma_f32_16x16x32_bf16(av[ks], b0[ks], a0, 0, 0, 0); a1 = __builtin_amdgcn_mfma_f32_16x16x32_bf16(av[ks], b1[ks], a1, 0, 0, 0); } }
#pragma unroll
          for (int j = 0; j < 4; ++j) { lrp[kh * 2048 + (rt * 16 + 4 * fq + j) * 32 + fr] = a0[j]; lrp[kh * 2048 + (rt * 16 + 4 * fq + j) * 32 + 16 + fr] = a1[j]; } }
        __syncthreads();
        for (int i = F.tid; i < 2048; i += 512) lrp[i] += lrp[2048 + i];
        __syncthreads();
        { const int ch = 2 * F.tid;
#pragma unroll 1
          for (int dir = 0; dir < 2; ++dir) {
              f32x2 w[16];
#pragma unroll
              for (int r = 0; r < 16; ++r) w[r] = *(const f32x2*)(w2 + (dir * 16 + r) * 1024 + ch);
              const f32x2 bb = *(const f32x2*)(gb + dir * 1024 + ch);
              bf16* Qd = QK + (size_t)dir * 2 * MH * 1024; bf16* Kd = Qd + (size_t)MH * 1024;
              bf16* KTc = KT + (((size_t)dir * (MH / 64) + cu) * 1024 + ch) * 64;
              f32x2 g = (f32x2){0.f, 0.f};
              unsigned qn8[8], kn8[8];
#pragma unroll
              for (int ii = 0; ii < 8; ++ii) { const int row = dir ? 63 - ii : ii;
                  qn8[ii] = *(const unsigned*)(proj + (size_t)(row0 + row) * 8192 + 2048 + ch); kn8[ii] = *(const unsigned*)(proj + (size_t)(row0 + row) * 8192 + 3072 + ch); }
              auto gate_group = [&](const int i8) {
                  unsigned kt0[8], kt1[8], qv8[8], kv8[8];
#pragma unroll
                  for (int ii = 0; ii < 8; ++ii) { qv8[ii] = qn8[ii]; kv8[ii] = kn8[ii]; }
                  { const int gn = i8 < 7 ? i8 + 1 : 7;
#pragma unroll
                      for (int ii = 0; ii < 8; ++ii) { const int rs = gn * 8 + ii, row = dir ? 63 - rs : rs;
                          qn8[ii] = *(const unsigned*)(proj + (size_t)(row0 + row) * 8192 + 2048 + ch); kn8[ii] = *(const unsigned*)(proj + (size_t)(row0 + row) * 8192 + 3072 + ch); } }
#pragma unroll
                  for (int ii = 0; ii < 8; ++ii) {
                      const int rs = i8 * 8 + ii, row = dir ? 63 - rs : rs;
                      f32x2 z = bb;
#pragma unroll
                      for (int r = 0; r < 16; ++r) { const float l = lrp[row * 32 + dir * 16 + r]; z += w[r] * l; }
                      g.x += (fminf(z.x, 0.f) - 0.6931471805599453f * __builtin_amdgcn_logf(1.0f + __builtin_amdgcn_exp2f(-1.4426950408889634f * fabsf(z.x)))) * 0.0625f; g.y += (fminf(z.y, 0.f) - 0.6931471805599453f * __builtin_amdgcn_logf(1.0f + __builtin_amdgcn_exp2f(-1.4426950408889634f * fabsf(z.y)))) * 0.0625f;
                      const float e0 = __expf(g.x), e1 = __expf(g.y), i0 = __builtin_amdgcn_rcpf(e0), i1 = __builtin_amdgcn_rcpf(e1);
                      const unsigned qv = qv8[ii], kv = kv8[ii];
                      const float q0 = bf2f(qv & 0xffffu) * 0.0625f * e0, q1 = bf2f(qv >> 16) * 0.0625f * e1, k0 = bf2f(kv & 0xffffu) * i0, k1 = bf2f(kv >> 16) * i1;
                      const unsigned kb0 = f2bf(k0), kb1 = f2bf(k1);
                      *(unsigned*)(Qd + (size_t)(row0 + row) * 1024 + ch) = pk2(q0, q1);
                      *(unsigned*)(Kd + (size_t)(row0 + row) * 1024 + ch) = kb0 | (kb1 << 16);
                      kt0[ii] = kb0; kt1[ii] = kb1;
                  }
                  v4u o0, o1; const int grp = dir ? 7 - i8 : i8;
                  if (dir == 0) { o0.x = kt0[0] | (kt0[1] << 16); o0.y = kt0[2] | (kt0[3] << 16); o0.z = kt0[4] | (kt0[5] << 16); o0.w = kt0[6] | (kt0[7] << 16);
                                  o1.x = kt1[0] | (kt1[1] << 16); o1.y = kt1[2] | (kt1[3] << 16); o1.z = kt1[4] | (kt1[5] << 16); o1.w = kt1[6] | (kt1[7] << 16); }
                  else          { o0.x = kt0[7] | (kt0[6] << 16); o0.y = kt0[5] | (kt0[4] << 16); o0.z = kt0[3] | (kt0[2] << 16); o0.w = kt0[1] | (kt0[0] << 16);
                                  o1.x = kt1[7] | (kt1[6] << 16); o1.y = kt1[5] | (kt1[4] << 16); o1.z = kt1[3] | (kt1[2] << 16); o1.w = kt1[1] | (kt1[0] << 16); }
                  *(v4u*)(KTc + grp * 8) = o0; *(v4u*)(KTc + 64 + grp * 8) = o1;
              };
              gate_group(0);
#pragma unroll 1
              for (int i8 = 1; i8 < 8; ++i8) gate_group(i8);
              f32x2 eo; eo.x = __expf(g.x); eo.y = __expf(g.y);
              *(f32x2*)(EB + ((size_t)cu * 2 + dir) * 1024 + ch) = eo;
          } }
        VM_WAIT(); __syncthreads();
        { const int dir = F.wave >> 2, hd = F.wave & 3, l31 = F.lane & 31, hh = F.lane >> 5;
          const bf16* Qp = QK + (size_t)dir * 2 * MH * 1024 + (size_t)row0 * 1024 + hd * 256; const bf16* Kp = Qp + (size_t)MH * 1024;
          bf16* Pp = PB + (((size_t)cu * 2 + dir) * 4 + hd) * 4096;
#pragma unroll 1
          for (int t = 0; t < 4; ++t) { const int ti = t >> 1, tj = t & 1;
              f32x16 acc;
#pragma unroll
              for (int r = 0; r < 16; ++r) acc[r] = 0.f;
              const bool dead = dir ? (ti == 1 && tj == 0) : (ti == 0 && tj == 1);
              if (!dead) {
                  const bf16* qa = Qp + (size_t)(32 * ti + l31) * 1024 + 8 * hh; const bf16* ka = Kp + (size_t)(32 * tj + l31) * 1024 + 8 * hh;
#pragma unroll 1
                  for (int k8 = 0; k8 < 2; ++k8) { bf16x8 qf[8], kf[8];
#pragma unroll
                      for (int ks = 0; ks < 8; ++ks) { qf[ks] = *(const bf16x8*)(qa + (k8 * 8 + ks) * 16); kf[ks] = *(const bf16x8*)(ka + (k8 * 8 + ks) * 16); }
#pragma unroll
                      for (int ks = 0; ks < 8; ++ks) acc = MFMA32(kf[ks], qf[ks], acc); } }
              const int i = 32 * ti + l31;
#pragma unroll
              for (int r4 = 0; r4 < 4; ++r4) { const int j0 = 32 * tj + 8 * r4 + 4 * hh; float v[4];
#pragma unroll
                  for (int jj = 0; jj < 4; ++jj) { const int j = j0 + jj; const bool keep = dir ? (j >= i) : (j <= i); v[jj] = keep ? acc[4 * r4 + jj] : 0.f; }
                  v2u o; o.x = pk2(v[0], v[1]); o.y = pk2(v[2], v[3]); *(v2u*)(Pp + i * 64 + j0) = o; }
          } }
        { const int nc = S >> 6, b = cu / nc, c = cu - b * nc, lane = F.lane; const size_t seq0 = (size_t)b * S;
          f32x4 fgv[4][2];
#pragma unroll
          for (int g = 0; g < 4; ++g) { fgv[g][0] = *(const f32x4*)(fg + g * 512 + lane * 8); fgv[g][1] = *(const f32x4*)(fg + g * 512 + lane * 8 + 4); }
          for (int t0 = F.wave * 8; t0 < 128; t0 += NWAVES * 8) {
              v4u ra[8], rb[8];
#pragma unroll
              for (int q4 = 0; q4 < 8; ++q4) { const int t = t0 + q4, r = 32 * c + (t >> 2), g = t & 3, r2 = (S - r) & (S - 1);
                  ra[q4] = *(const v4u*)(proj + (seq0 + r) * 8192 + g * 512 + lane * 8); rb[q4] = *(const v4u*)(proj + (seq0 + r2) * 8192 + g * 512 + lane * 8); }
#pragma unroll
              for (int q4 = 0; q4 < 8; ++q4) { const int t = t0 + q4, r = 32 * c + (t >> 2), g = t & 3;
                  float v1[8], v2[8];
#pragma unroll
                  for (int j = 0; j < 4; ++j) { v1[2 * j] = bf2f(ra[q4][j] & 0xffffu); v1[2 * j + 1] = bf2f(ra[q4][j] >> 16); v2[2 * j] = bf2f(rb[q4][j] & 0xffffu); v2[2 * j + 1] = bf2f(rb[q4][j] >> 16); }
                  float s1 = 0.f, s2 = 0.f;
#pragma unroll
                  for (int j = 0; j < 8; ++j) { s1 += v1[j]; s2 += v2[j]; }
                  const float m1 = wave_sum(s1) * (1.0f / 512.0f), m2 = wave_sum(s2) * (1.0f / 512.0f); float q1 = 0.f, q2 = 0.f;
#pragma unroll
                  for (int j = 0; j < 8; ++j) { v1[j] -= m1; q1 += v1[j] * v1[j]; v2[j] -= m2; q2 += v2[j] * v2[j]; }
                  const float r1 = rsqrtf(wave_sum(q1) * (1.0f / 512.0f) + LN_EPS), r2s = rsqrtf(wave_sum(q2) * (1.0f / 512.0f) + LN_EPS);
                  const f32x4 g0 = fgv[q4 & 3][0], g1 = fgv[q4 & 3][1];
                  float e[8], o[8];
#pragma unroll
                  for (int j = 0; j < 8; ++j) { const float gg = (j < 4) ? g0[j & 3] : g1[j & 3]; const float a1 = v1[j] * r1 * gg, a2 = (r == 0) ? 0.f : v2[j] * r2s * gg; e[j] = a1 + a2; o[j] = a1 - a2; }
                  bf16* fb = un + ((size_t)(b * 4 + g) * S + r) * 512 + lane * 8;
                  v4u we; we.x = pk2(e[0], e[1]); we.y = pk2(e[2], e[3]); we.z = pk2(e[4], e[5]); we.w = pk2(e[6], e[7]);
                  *(v4u*)fb = we;
                  if (r != 0) { v4u wo; wo.x = pk2(o[0], o[1]); wo.y = pk2(o[2], o[3]); wo.z = pk2(o[4], o[5]); wo.w = pk2(o[6], o[7]); *(v4u*)(fb + (size_t)(S >> 1) * 512) = wo; }
              } }
          LAS float* nyl = (LAS float*)(F.lds + RING_OFF + 16384);
          if (F.wave < 4) { const int g = F.wave; const v4u raw = *(const v4u*)(proj + (seq0 + (S >> 1)) * 8192 + g * 512 + lane * 8);
              float v[8];
#pragma unroll
              for (int j = 0; j < 4; ++j) { v[2 * j] = bf2f(raw[j] & 0xffffu); v[2 * j + 1] = bf2f(raw[j] >> 16); }
              float sm = 0.f;
#pragma unroll
              for (int j = 0; j < 8; ++j) sm += v[j];
              const float mean = wave_sum(sm) * (1.0f / 512.0f); float q = 0.f;
#pragma unroll
              for (int j = 0; j < 8; ++j) { v[j] -= mean; q += v[j] * v[j]; }
              const float rstd = rsqrtf(wave_sum(q) * (1.0f / 512.0f) + LN_EPS);
              const f32x4 g0 = *(const f32x4*)(fg + g * 512 + lane * 8), g1 = *(const f32x4*)(fg + g * 512 + lane * 8 + 4);
              f32x4 n0, n1;
#pragma unroll
              for (int j = 0; j < 4; ++j) { n0[j] = v[j] * rstd * g0[j]; n1[j] = v[4 + j] * rstd * g1[j]; }
              *(LAS f32x4*)(nyl + g * 512 + lane * 8) = n0; *(LAS f32x4*)(nyl + g * 512 + lane * 8 + 4) = n1;
              if (c == 0) *(v4u*)(un + ((size_t)(b * 4 + g) * S + (S >> 1)) * 512 + lane * 8) = (v4u){0u, 0u, 0u, 0u}; }
          __syncthreads();
          { const int sl = 512 / nc; const float isq = rsqrtf((float)S);
            for (int idx = F.wave; idx < 4 * sl; idx += NWAVES) { const int g = idx / sl, cp = c * sl + idx % sl;
                const v4u dw = *(const v4u*)(Dc + (size_t)cp * 512 + lane * 8);
                const f32x4 n0 = *(const LAS f32x4*)(nyl + g * 512 + lane * 8), n1 = *(const LAS f32x4*)(nyl + g * 512 + lane * 8 + 4);
                float d = bf2f(dw.x & 0xffffu) * n0[0] + bf2f(dw.x >> 16) * n0[1] + bf2f(dw.y & 0xffffu) * n0[2] + bf2f(dw.y >> 16) * n0[3]
                        + bf2f(dw.z & 0xffffu) * n1[0] + bf2f(dw.z >> 16) * n1[1] + bf2f(dw.w & 0xffffu) * n1[2] + bf2f(dw.w >> 16) * n1[3];
                d = wave_sum(d);
                if (lane == 0) nyq[(b * 4 + g) * 512 + cp] = d * isq; } } }
        __syncthreads();
    }
}

constexpr int GS_VT = 0, GS_VT_P = 72, GS_ST = 9216, GS_ST_P = 264, GS_RED = GS_ST + 64 * GS_ST_P * 2, GS_PL = GS_RED + 16384, GS_PL_P = 72, GS_EL = GS_PL + 64 * GS_PL_P * 2, GS_QL = GS_EL + 1024, GS_QL_P = 264, GS_KL = GS_QL + 64 * GS_QL_P * 2, GS_KL_P = 72, GS_END = GS_KL + 256 * GS_KL_P * 2;
static_assert(GS_RED % 16 == 0 && GS_PL % 16 == 0 && GS_EL % 16 == 0 && GS_QL % 16 == 0 && GS_KL % 16 == 0 && GS_END <= LDSCTL_OFF, "scan LDS map");
#define WG_BAR() do { asm volatile("s_waitcnt lgkmcnt(0)" ::: "memory"); __builtin_amdgcn_s_barrier(); asm volatile("" ::: "memory"); } while (0)
struct ScanOps { v4u pv, pp, pq[4], pk[4]; f32x4 pe; };
__device__ __forceinline__ void scan_load(ScanOps& o, const bf16* proj, const bf16* Qd, const bf16* KTd, const bf16* PB, const float* EB, int cg, int dir, int hd, int slab, int tid, int w, int l31, int hh, int ti, int kh) {
    const int row0 = cg * 64, tok = tid >> 3, c8 = tid & 7;
    o.pv = *(const v4u*)(proj + (size_t)(row0 + tok) * 8192 + 4096 + hd * 512 + slab * 64 + c8 * 8);
    o.pp = *(const v4u*)(PB + (((size_t)cg * 2 + dir) * 4 + hd) * 4096 + tok * 64 + c8 * 8);
    o.pe = *(const f32x4*)(EB + ((size_t)cg * 2 + dir) * 1024 + hd * 256 + 4 * (tid & 63));
#pragma unroll
    for (int i = 0; i < 4; ++i) { const int c = tid + 512 * i; o.pq[i] = *(const v4u*)(Qd + (size_t)(row0 + (c >> 5)) * 1024 + hd * 256 + (c & 31) * 8); }
    const bf16* ka = KTd + ((size_t)cg * 1024 + hd * 256) * 64;
#pragma unroll
    for (int i = 0; i < 4; ++i) o.pk[i] = *(const v4u*)(ka + (size_t)(tid + 512 * i) * 8);
}
__device__ __forceinline__ void gla_scan_phase(Frame& F, const bf16* proj, const bf16* QK, const bf16* KT, const bf16* PB, const float* EB, bf16* O, int S, int nb, int ostride, int hmask) {
    frame_refresh(F);
    LAS bf16* VT = (LAS bf16*)(F.lds + RING_OFF + GS_VT); LAS bf16* ST = (LAS bf16*)(F.lds + RING_OFF + GS_ST); LAS float* RED = (LAS float*)(F.lds + RING_OFF + GS_RED);
    LAS bf16* PL = (LAS bf16*)(F.lds + RING_OFF + GS_PL); LAS float* EL = (LAS float*)(F.lds + RING_OFF + GS_EL); LAS bf16* QL = (LAS bf16*)(F.lds + RING_OFF + GS_QL); LAS bf16* KL = (LAS bf16*)(F.lds + RING_OFF + GS_KL);
    const int nc = S / 64, nunits = nb * 64;
    const int w = F.wave, l31 = F.lane & 31, hh = F.lane >> 5;
    const int t = w & 3, ti = t >> 1, tj = t & 1, kh = w >> 2;
    for (int u = blockIdx.x; u < nunits; u += F.G) {
        const int slab = u & 7, dir = (u >> 3) & 1, hd = (u >> 4) & 3, b = u >> 6;
        const bf16* Qd = QK + (size_t)dir * 2 * MH * 1024; const bf16* KTd = KT + (size_t)dir * (MH / 64) * 1024 * 64;
        f32x16 s0, s1;
#pragma unroll
        for (int r = 0; r < 16; ++r) { s0[r] = 0.f; s1[r] = 0.f; }
        ScanOps cur, nxt;
        f32x16 pend; bf16* pend_op = O; bool have_pend = false;
#pragma unroll
        for (int r = 0; r < 16; ++r) pend[r] = 0.f;
        scan_load(cur, proj, Qd, KTd, PB, EB, b * nc + (dir ? nc - 1 : 0), dir, hd, slab, F.tid, w, l31, hh, ti, kh);
        nxt = cur;
#pragma unroll 1
        for (int step = 0; step < nc; ++step) {
            const int c = dir ? nc - 1 - step : step, cg = b * nc + c, row0 = cg * 64;
            { const int tok = F.tid >> 3, c8 = F.tid & 7;
              v4u rot = cur.pv;
              if (c8 & 4) rot = (v4u){rot[2], rot[3], rot[0], rot[1]};
              if (c8 & 2) rot = (v4u){rot[1], rot[2], rot[3], rot[0]};
              if (c8 & 1) rot = (v4u){__builtin_amdgcn_alignbit(rot[1], rot[0], 16), __builtin_amdgcn_alignbit(rot[2], rot[1], 16), __builtin_amdgcn_alignbit(rot[3], rot[2], 16), __builtin_amdgcn_alignbit(rot[0], rot[3], 16)};
#pragma unroll
              for (int j = 0; j < 8; ++j) { const int e = (j + c8) & 7; VT[(c8 * 8 + e) * GS_VT_P + tok] = (bf16)((j & 1) ? (rot[j >> 1] >> 16) : (rot[j >> 1] & 0xffffu)); }
              *(LAS v4u*)(PL + tok * GS_PL_P + c8 * 8) = cur.pp;
#pragma unroll
              for (int i = 0; i < 4; ++i) { const int c = F.tid + 512 * i; *(LAS v4u*)(QL + (c >> 5) * GS_QL_P + (c & 31) * 8) = cur.pq[i]; *(LAS v4u*)(KL + (c >> 3) * GS_KL_P + (c & 7) * 8) = cur.pk[i]; }
              if (F.tid < 64) *(LAS f32x4*)(EL + 4 * F.tid) = cur.pe; }
#pragma unroll
            for (int r4 = 0; r4 < 4; ++r4) { const int dk = 32 * w + 8 * r4 + 4 * hh;
                v2u o0, o1; o0.x = pk2(s0[4 * r4], s0[4 * r4 + 1]); o0.y = pk2(s0[4 * r4 + 2], s0[4 * r4 + 3]); o1.x = pk2(s1[4 * r4], s1[4 * r4 + 1]); o1.y = pk2(s1[4 * r4 + 2], s1[4 * r4 + 3]);
                *(LAS v2u*)(ST + l31 * GS_ST_P + dk) = o0; *(LAS v2u*)(ST + (32 + l31) * GS_ST_P + dk) = o1; }
            WG_BAR();
            if (kh == 0 && have_pend) {
#pragma unroll
                for (int r = 0; r < 16; ++r) pend_op[(size_t)crow(r, hh) * ostride] = (bf16)f2bf(pend[r]); }
            if (step + 1 < nc) scan_load(nxt, proj, Qd, KTd, PB, EB, b * nc + (dir ? nc - 2 - step : step + 1), dir, hd, slab, F.tid, w, l31, hh, ti, kh);
            f32x16 acc;
#pragma unroll
            for (int r = 0; r < 16; ++r) acc[r] = 0.f;
            { const LAS bf16* sb = ST + (32 * tj + l31) * GS_ST_P + kh * 128 + 8 * hh;
              bf16x8 bs[4];
#pragma unroll
              for (int ks = 0; ks < 4; ++ks) bs[ks] = *(const LAS bf16x8*)(sb + ks * 16);
              const LAS bf16* vb0 = VT + l31 * GS_VT_P + 8 * hh; const LAS bf16* vb1 = VT + (32 + l31) * GS_VT_P + 8 * hh;
              bf16x8 v0[4], v1[4];
#pragma unroll
              for (int ks = 0; ks < 4; ++ks) { v0[ks] = *(const LAS bf16x8*)(vb0 + ks * 16); v1[ks] = *(const LAS bf16x8*)(vb1 + ks * 16); }
              const LAS bf16* qb = QL + (32 * ti + l31) * GS_QL_P + kh * 128 + 8 * hh;
              bf16x8 qs[4];
#pragma unroll
              for (int ks = 0; ks < 4; ++ks) qs[ks] = *(const LAS bf16x8*)(qb + ks * 16);
#pragma unroll
              for (int ks = 0; ks < 4; ++ks) acc = MFMA32(qs[ks], bs[ks], acc);
#pragma unroll
              for (int ks = 0; ks < 4; ++ks) { bs[ks] = *(const LAS bf16x8*)(sb + (ks + 4) * 16); qs[ks] = *(const LAS bf16x8*)(qb + (ks + 4) * 16); }
#pragma unroll
              for (int ks = 0; ks < 4; ++ks) acc = MFMA32(qs[ks], bs[ks], acc);
              { const LAS bf16* kb = KL + (32 * w + l31) * GS_KL_P + 8 * hh;
#pragma unroll
                for (int ks = 0; ks < 4; ++ks) qs[ks] = *(const LAS bf16x8*)(kb + ks * 16); }
#pragma unroll
              for (int ks = 0; ks < 4; ++ks) { s0 = MFMA32(qs[ks], v0[ks], s0); s1 = MFMA32(qs[ks], v1[ks], s1); }
              if (kh == 0) { const LAS bf16* pa = PL + (32 * ti + l31) * GS_PL_P + 8 * hh; bf16x8 pf[4];
#pragma unroll
                  for (int ks = 0; ks < 4; ++ks) pf[ks] = *(const LAS bf16x8*)(pa + ks * 16);
#pragma unroll
                  for (int ks = 0; ks < 4; ++ks) acc = MFMA32(pf[ks], tj ? v1[ks] : v0[ks], acc); }
#pragma unroll
              for (int r4 = 0; r4 < 4; ++r4) { const f32x4 e = *(const LAS f32x4*)(EL + 32 * w + 8 * r4 + 4 * hh);
#pragma unroll
                  for (int jj = 0; jj < 4; ++jj) { s0[4 * r4 + jj] *= e[jj]; s1[4 * r4 + jj] *= e[jj]; } } }
            if (kh == 1) {
#pragma unroll
                for (int r = 0; r < 16; ++r) RED[t * 1024 + r * 64 + F.lane] = acc[r]; }
            WG_BAR();
            if (kh == 0) { pend_op = O + (size_t)dir * MH * 2048 + (size_t)(row0 + 32 * ti) * ostride + (hd & hmask) * 512 + slab * 64 + 32 * tj + l31; have_pend = true;
#pragma unroll
                for (int r = 0; r < 16; ++r) pend[r] = acc[r] + RED[t * 1024 + r * 64 + F.lane]; }
            cur = nxt;
        }
        if (kh == 0 && have_pend) {
#pragma unroll
            for (int r = 0; r < 16; ++r) pend_op[(size_t)crow(r, hh) * ostride] = (bf16)f2bf(pend[r]); }
        WG_BAR();
    }
}
constexpr int AT_KP = 72, AT_VP = 392, AT_BP = 264;
constexpr int AT_K = 0, AT_V = 384 * AT_KP * 2, AT_B = AT_V + 64 * AT_VP * 2, AT_END = AT_B + 8 * AT_BP * 4;
static_assert(AT_V % 16 == 0 && AT_B % 16 == 0 && AT_END <= RING_BYTES, "attention LDS map");
__device__ __forceinline__ unsigned cvtpk(float lo, float hi) { f32x2_t v = {lo, hi}; bf16x2_t b = __builtin_convertvector(v, bf16x2_t); return __builtin_bit_cast(unsigned, b); }
__device__ __forceinline__ void attn_phase(Frame& F, const bf16* cp, const float* table, const float* sinks, bf16* ao) {
    frame_refresh(F);
    LAS bf16* KL = (LAS bf16*)(F.lds + RING_OFF + AT_K); LAS bf16* VT = (LAS bf16*)(F.lds + RING_OFF + AT_V); LAS float* BL = (LAS float*)(F.lds + RING_OFF + AT_B);
    const float L2E = 1.4426950408889634f, C1 = 0.125f * 1.4426950408889634f;
    const int w = F.wave, l31 = F.lane & 31, hh = F.lane >> 5;
    for (int u = blockIdx.x; u < (M / 128) * 8; u += F.G) {
        const int kvh = u & 7, qb = u >> 3, row0 = qb * 128;
        int S, p0; if (row0 < MH) { S = 2048; p0 = row0 & 2047; } else { S = 4096; p0 = (row0 - MH) & 4095; }
        const bool lo_ok = p0 > 0, hi_ok = p0 + 128 < S;
        v4u kvr[6], vvr[6];
#pragma unroll
        for (int it = 0; it < 6; ++it) { const int c = F.tid + 512 * it, wr = c >> 3, c8 = c & 7;
            const bool valid = (wr >= 128 || lo_ok) && (wr < 256 || hi_ok);
            kvr[it] = (v4u){0u, 0u, 0u, 0u}; vvr[it] = kvr[it];
            if (valid) { const bf16* src = cp + (size_t)(row0 - 128 + wr) * C_IN + 4096 + kvh * 64 + c8 * 8; kvr[it] = *(const v4u*)src; vvr[it] = *(const v4u*)(src + 512); } }
#pragma unroll
        for (int it = 0; it < 6; ++it) { const int c = F.tid + 512 * it, wr = c >> 3, c8 = c & 7;
            *(LAS v4u*)(KL + wr * AT_KP + c8 * 8) = kvr[it];
            v4u rot = vvr[it];
            if (c8 & 4) rot = (v4u){rot[2], rot[3], rot[0], rot[1]};
            if (c8 & 2) rot = (v4u){rot[1], rot[2], rot[3], rot[0]};
            if (c8 & 1) rot = (v4u){__builtin_amdgcn_alignbit(rot[1], rot[0], 16), __builtin_amdgcn_alignbit(rot[2], rot[1], 16), __builtin_amdgcn_alignbit(rot[3], rot[2], 16), __builtin_amdgcn_alignbit(rot[0], rot[3], 16)};
#pragma unroll
            for (int j = 0; j < 8; ++j) { const int e = (j + c8) & 7; VT[(c8 * 8 + e) * AT_VP + wr] = (bf16)((j & 1) ? (rot[j >> 1] >> 16) : (rot[j >> 1] & 0xffffu)); } }
        for (int e = F.tid; e < 8 * 257; e += 512) { const int hw = e / 257, t = e - hw * 257; BL[hw * AT_BP + t] = table[t5_bucket(t - 128) * 64 + kvh * 8 + hw] * L2E; }
        const int h = kvh * 8 + w; const float sink2 = sinks[h] * L2E;
        bf16x8 qn[4];
#pragma unroll
        for (int ks = 0; ks < 4; ++ks) qn[ks] = *(const bf16x8*)(cp + (size_t)(row0 + l31) * C_IN + h * 64 + 16 * ks + 8 * hh);
        __syncthreads();
#pragma unroll 1
        for (int qi = 0; qi < 4; ++qi) {
            const int qrow = row0 + 32 * qi + l31;
            bf16x8 qf[4];
#pragma unroll
            for (int ks = 0; ks < 4; ++ks) qf[ks] = qn[ks];
            if (qi < 3) {
#pragma unroll
                for (int ks = 0; ks < 4; ++ks) qn[ks] = *(const bf16x8*)(cp + (size_t)(qrow + 32) * C_IN + h * 64 + 16 * ks + 8 * hh); }
            float m = sink2, lsum = hh ? 0.f : 1.f;
            f32x16 o0, o1;
#pragma unroll
            for (int r = 0; r < 16; ++r) { o0[r] = 0.f; o1[r] = 0.f; }
#pragma unroll 3
            for (int kj = qi; kj <= qi + 8; ++kj) {
                if ((kj < 4 && !lo_ok) || (kj >= 8 && !hi_ok)) continue;
                f32x16 s;
#pragma unroll
                for (int r = 0; r < 16; ++r) s[r] = 0.f;
#pragma unroll
                for (int ks = 0; ks < 4; ++ks) { const bf16x8 kf = *(const LAS bf16x8*)(KL + (32 * kj + l31) * AT_KP + 16 * ks + 8 * hh); s = MFMA32(kf, qf[ks], s); }
                const int tb = 32 * (kj - qi) - l31;
                float mx = -INFINITY;
                if (kj == qi || kj == qi + 8) {
#pragma unroll
                    for (int r = 0; r < 16; ++r) { const int t = tb + crow(r, hh); const int tc = t < 0 ? 0 : (t > 256 ? 256 : t);
                        float x = fmaf(s[r], C1, BL[w * AT_BP + tc]); x = (t == tc) ? x : -INFINITY; s[r] = x; mx = fmaxf(mx, x); }
                } else {
#pragma unroll
                    for (int r = 0; r < 16; ++r) { const float x = fmaf(s[r], C1, BL[w * AT_BP + tb + crow(r, hh)]); s[r] = x; mx = fmaxf(mx, x); }
                }
                mx = fmaxf(mx, __shfl_xor(mx, 32));
                if (__builtin_amdgcn_ballot_w64(mx > m + 8.0f) != 0ull) {
                    const float mn = fmaxf(m, mx), sc = __builtin_amdgcn_exp2f(m - mn); m = mn; lsum *= sc;
#pragma unroll
                    for (int r = 0; r < 16; ++r) { o0[r] *= sc; o1[r] *= sc; }
                }
                float ps = 0.f;
#pragma unroll
                for (int r = 0; r < 16; ++r) { const float p = __builtin_amdgcn_exp2f(s[r] - m); s[r] = p; ps += p; }
                lsum += ps;
#pragma unroll
                for (int s2 = 0; s2 < 2; ++s2) {
                    v4u pw; pw.x = cvtpk(s[8 * s2], s[8 * s2 + 1]); pw.y = cvtpk(s[8 * s2 + 2], s[8 * s2 + 3]); pw.z = cvtpk(s[8 * s2 + 4], s[8 * s2 + 5]); pw.w = cvtpk(s[8 * s2 + 6], s[8 * s2 + 7]);
                    const bf16x8 pb = __builtin_bit_cast(bf16x8, pw);
                    const LAS bf16* v0 = VT + l31 * AT_VP + 32 * kj + 16 * s2 + 4 * hh; const LAS bf16* v1 = v0 + 32 * AT_VP;
                    const v2u a00 = *(const LAS v2u*)v0, a01 = *(const LAS v2u*)(v0 + 8), a10 = *(const LAS v2u*)v1, a11 = *(const LAS v2u*)(v1 + 8);
                    const v4u va0 = (v4u){a00.x, a00.y, a01.x, a01.y}, va1 = (v4u){a10.x, a10.y, a11.x, a11.y};
                    o0 = MFMA32(__builtin_bit_cast(bf16x8, va0), pb, o0); o1 = MFMA32(__builtin_bit_cast(bf16x8, va1), pb, o1);
                }
            }
            const float inv = 1.0f / (lsum + __shfl_xor(lsum, 32));
            bf16* op = ao + (size_t)qrow * D + h * 64 + 4 * hh;
#pragma unroll
            for (int r4 = 0; r4 < 4; ++r4) {
                v2u a, b; a.x = cvtpk(o0[4 * r4] * inv, o0[4 * r4 + 1] * inv); a.y = cvtpk(o0[4 * r4 + 2] * inv, o0[4 * r4 + 3] * inv);
                b.x = cvtpk(o1[4 * r4] * inv, o1[4 * r4 + 1] * inv); b.y = cvtpk(o1[4 * r4 + 2] * inv, o1[4 * r4 + 3] * inv);
                *(v2u*)(op + 8 * r4) = a; *(v2u*)(op + 32 + 8 * r4) = b; }
        }
        __syncthreads();
    }
}
struct Args { const float* in[17]; float* out; unsigned char* ws; int ph_lo, ph_hi; };
constexpr int N_PHASES = 20;
__global__ void __launch_bounds__(NWAVES * 64, 2) mega_fwd(Args args) {
    extern __shared__ __attribute__((aligned(16))) unsigned char lds[];
    Frame F;
    F.lds = (LAS unsigned char*)lds;
    F.MISC = (volatile LAS unsigned*)(F.lds + MISC_OFF);
    F.tid = threadIdx.x; F.lane = F.tid & 63; F.wave = __builtin_amdgcn_readfirstlane(F.tid >> 6);
    F.G = gridDim.x; F.gw = blockIdx.x * NWAVES + F.wave; F.NGW = F.G * NWAVES;
    unsigned char* ws = args.ws;
    F.ctl = (unsigned*)(ws + WS_CTL);
    for (int u = F.tid; u < (LDS_BYTES - LDSCTL_OFF) / 4; u += NWAVES * 64) ((LAS unsigned*)(F.lds + LDSCTL_OFF))[u] = 0u;
    __syncthreads();
    XcdBarrier bar = xcd_barrier_post(F.ctl + CW_BAR, F.MISC + 8);

    const float* x_prompt = args.in[0]; const float* x_sample = args.in[1]; const float* table = args.in[2];
    const float* ab_w_in = args.in[3]; const float* ab_fg = args.in[4]; const float* ab_w2 = args.in[5]; const float* ab_gb = args.in[6];
    const float* ab_hg = args.in[7]; const float* ab_w_out = args.in[8]; const float* c_w_in = args.in[9]; const float* c_sinks = args.in[10];
    const float* c_w_out = args.in[11]; const float* ffn_w1 = args.in[12]; const float* ffn_w3 = args.in[13]; const float* ffn_w2 = args.in[14];
    const float* ln_g = args.in[15]; const float* ln_b = args.in[16];
    float* out = args.out;
    bf16 *Win = (bf16*)(ws + WS_WIN), *Wout = (bf16*)(ws + WS_WOUT), *Cin = (bf16*)(ws + WS_CIN), *Cout = (bf16*)(ws + WS_COUT), *Dc = (bf16*)(ws + WS_DFTC), *DsP = (bf16*)(ws + WS_DFTP), *DsS = (bf16*)(ws + WS_DFTS);
    bf16 *W13 = (bf16*)(ws + WS_W13), *W2 = (bf16*)(ws + WS_W2), *xb = (bf16*)(ws + WS_XB), *W13b = (bf16*)(ws + WS_W13_L1), *W2b = (bf16*)(ws + WS_W2_L1);
    bf16 *proj = (bf16*)(ws + WS_PROJ), *un = (bf16*)(ws + WS_UN), *ucs = (bf16*)(ws + WS_UCS), *mix = (bf16*)(ws + WS_MIX);
    float *EB = (float*)(ws + WS_EB); bf16* O = (bf16*)(ws + WS_O);
    float* stats = (float*)(ws + WS_STATS); float* csv = (float*)(ws + WS_CS);
    bf16 *QK = (bf16*)(ws + WS_QK), *KT = (bf16*)(ws + WS_KT), *PB = (bf16*)(ws + WS_PB);
    bf16 *hid = (bf16*)(ws + WS_HID), *cproj = (bf16*)(ws + WS_CPROJ), *atto = (bf16*)(ws + WS_ATTO);

    const int lo = args.ph_lo, hi = args.ph_hi;
#define IN(k) (lo <= (k) && (k) < hi)
#define SEAM(k) do { if (IN(k) && IN((k) + 1)) xcd_barrier(bar); } while (0)
    typedef pg8::StaticOrder SO;

    if (IN(0)) {
        cvt_rows_bf16(F, x_prompt, xb, (size_t)MH * D / 8);
        cvt_rows_bf16(F, x_sample, xb + (size_t)MH * D, (size_t)MH * D / 8);
        cvt_weight(F, ab_w_in, D, AB_IN, Win, 0, 0);
        cvt_weight(F, ab_w_out, D, D, Wout, 0, 0);
        gen_dftc(F, Dc); gen_dfts(F, DsP, 11); gen_dfts(F, DsS, 12);
        __syncthreads();
    }
    SEAM(0);
#pragma unroll 1
    for (int half = 0; half < 2; ++half) {
        const int pb = 1 + 5 * half;
        const int lgS = half ? 12 : 11, S = 1 << lgS, nb = half ? 4 : 8, nz = nb * 4;
        const bf16* xbh = xb + (size_t)half * MH * D; bf16* mixh = mix + (size_t)half * MH * D; const bf16* Ds = half ? DsS : DsP;
        if (IN(pb)) {
            const bool early = ((int)blockIdx.x & 1) != 0;
#pragma unroll 1
            for (int pass = 0; pass < 2; ++pass) {
                if ((pass == 0) == early) {
                    __syncthreads();
                    if (half == 0) {
                        cvt_weight_fold(F, ffn_w1, D, DFF, W13, 128, 0, ln_g, ln_b, csv + CS13, csv + BW13);
                        cvt_weight_fold(F, ffn_w3, D, DFF, W13, 128, 1, ln_g, ln_b, csv + CS13, csv + BW13);
                    } else {
                        cvt_weight(F, ffn_w2, DFF, D, W2, 0, 0);
                        cvt_weight_fold(F, c_w_in, D, C_IN, Cin, 0, 0, ln_g + D, ln_b + D, csv + CSC, csv + BWC);
                        cvt_weight(F, c_w_out, D, D, Cout, 0, 0);
                    }
                    __syncthreads();
                }
                if (pass == 0) {
                    pg8::Gemm g{xbh, Win, MH, 8192, D}; SO So; So.init(MH, 8192, F.G, (int)blockIdx.x);
                    pg8::EpiStoreBf E{proj, 8192};
                    pg8::gemm_phase<pg8::EpiStoreBf, SO, true, true>(F.lds + RING_OFF, g, So, E);
                }
            }
        }
        SEAM(pb);
        if (IN(pb + 1)) p2_phase(F, xbh, Win + (size_t)8192 * D, ab_w2, ab_gb, proj, ab_fg, un, QK, KT, PB, EB, Dc, csv + NYQ, S);
        SEAM(pb + 1);
        if (IN(pb + 2)) {
            pg8::Gemm g{Dc, un, 1024, nz * S, 512}; pg8::FoldOrder So; So.init(512, nz * S, F.G, (int)blockIdx.x); So.lgS = lgS;
            pg8::EpiF1 E{ucs, lgS};
            pg8::gemm_phase<pg8::EpiF1, pg8::FoldOrder, true, true>(F.lds + RING_OFF, g, So, E);
        }
        SEAM(pb + 2);
        if (IN(pb + 3)) {
            { pg8::Gemm g{Ds, ucs, S / 2, nz * 512, S}; SO So; So.init(S / 2, nz * 512, F.G, (int)blockIdx.x);
            pg8::EpiF2 E{mixh, S, csv + NYQ};
            pg8::gemm_phase<pg8::EpiF2, SO, true, true>(F.lds + RING_OFF, g, So, E);
            __syncthreads(); }
            gla_scan_phase(F, proj, QK, KT, PB, EB, O, S, nb, 2048, 3);
        }
        SEAM(pb + 3);
        if (IN(pb + 4)) { f2_mid_row(F, ucs, csv + NYQ, mixh, S, nz); headnorm_phase(F, O, proj, ab_hg, mixh); }
        SEAM(pb + 4);
    }
#pragma unroll 1
    for (int layer = 0; layer < 2; ++layer) {
        const int ob = layer ? 16 : 11;
        float* st_mix = stats + (size_t)(2 * layer) * 2 * M;
        float* st_ffn = stats + (size_t)1 * 2 * M;
        if (layer == 1) {
            if (IN(14)) {
                pg8::Gemm g{xb, Cin, M, C_IN, D}; SO So; So.init(M, C_IN, F.G, (int)blockIdx.x);
                pg8::EpiStoreBfFold E{cproj, C_IN, st_ffn, csv + CSC, csv + BWC};
                pg8::gemm_phase<pg8::EpiStoreBfFold, SO, true, true>(F.lds + RING_OFF, g, So, E);
            }
            SEAM(14);
            if (IN(15)) attn_phase(F, cproj, table, c_sinks, atto);
            SEAM(15);
        }
        if (IN(ob)) {
            pg8::Gemm g{layer ? atto : mix, layer ? Cout : Wout, M, D, D}; SO So; So.init(M, D, F.G, (int)blockIdx.x);
            if (layer == 0) { pg8::EpiResid<false> E{x_prompt, x_sample - (size_t)MH * D, nullptr, nullptr, xb, nullptr, nullptr, nullptr, st_mix, ALPHA};
                pg8::gemm_phase<pg8::EpiResid<false>, SO, true, true>(F.lds + RING_OFF, g, So, E);
 }
            else { pg8::EpiResid<true> E{nullptr, nullptr, nullptr, xb, xb, st_ffn, ln_g + D, ln_b + D, st_mix, ALPHA};
                pg8::gemm_phase<pg8::EpiResid<true>, SO, true, true>(F.lds + RING_OFF, g, So, E); }
        }
        SEAM(ob);
        if (IN(ob + 1)) {
            const bool early = ((int)blockIdx.x & 1) != 0;
#pragma unroll 1
            for (int pass = 0; pass < 2; ++pass) {
                if ((pass == 0) == early) {
                    __syncthreads();
                    if (layer == 0) {
                        cvt_weight_fold(F, ffn_w1 + (size_t)D * DFF, D, DFF, W13b, 128, 0, ln_g + 2 * D, ln_b + 2 * D, csv + CS13_L1, csv + BW13_L1);
                        cvt_weight_fold(F, ffn_w3 + (size_t)D * DFF, D, DFF, W13b, 128, 1, ln_g + 2 * D, ln_b + 2 * D, csv + CS13_L1, csv + BW13_L1);
                    } else cvt_weight(F, ffn_w2 + (size_t)DFF * D, DFF, D, W2b, 0, 0);
                    __syncthreads();
                }
                if (pass == 0) {
                    pg8::Gemm g{xb, layer ? W13b : W13, M, 2 * DFF, D}; SO So; So.init(M, 2 * DFF, F.G, (int)blockIdx.x);
                    pg8::EpiSwiGLU E{hid, DFF, st_mix, csv + (layer ? CS13_L1 : CS13), csv + (layer ? BW13_L1 : BW13)};
                    pg8::gemm_phase<pg8::EpiSwiGLU, SO, true, true>(F.lds + RING_OFF, g, So, E);
                }
            }
        }
        SEAM(ob + 1);
        if (IN(ob + 2)) {
            pg8::Gemm g{hid, layer ? W2b : W2, M, D, DFF}; pg8::ReverseOrder So; So.init(M, D, F.G, (int)blockIdx.x);
            pg8::EpiResid<true> E{nullptr, nullptr, layer ? out : nullptr, xb, layer ? nullptr : xb, st_mix, ln_g + (size_t)(2 * layer) * D, ln_b + (size_t)(2 * layer) * D, layer ? nullptr : st_ffn, ALPHA};
            pg8::gemm_phase<pg8::EpiResid<true>, pg8::ReverseOrder, true, true>(F.lds + RING_OFF, g, So, E);
        }
        SEAM(ob + 2);
        if (layer == 1) {
            if (IN(19)) ln_phase(F, out, out, ln_g + 3 * D, ln_b + 3 * D, (bf16*)nullptr);
        }
    }
#undef IN
#undef SEAM
}

extern "C" void kernel_launch(void* const* d_in, const int* in_sizes, int n_in, void* d_out, int out_size, void* d_ws, size_t ws_size, hipStream_t stream) {
    static int grid = 0;
    if (grid == 0) {
        if (n_in != 17 || out_size != M * D || ws_size < WS_NEED) { fprintf(stderr, "kernel_launch: unexpected sizes: n_in %d out %d ws %zu (need %zu); nothing launched\n", n_in, out_size, ws_size, (size_t)WS_NEED); grid = -1; return; }
        int dev = 0, cus = 0, per_cu = 0;
        if (hipGetDevice(&dev) != hipSuccess || hipDeviceGetAttribute(&cus, hipDeviceAttributeMultiprocessorCount, dev) != hipSuccess) { fprintf(stderr, "kernel_launch: device query failed\n"); grid = -1; return; }
        if (hipFuncSetAttribute((const void*)mega_fwd, hipFuncAttributeMaxDynamicSharedMemorySize, LDS_BYTES) != hipSuccess) { fprintf(stderr, "kernel_launch: hipFuncSetAttribute failed\n"); grid = -1; return; }
        if (hipOccupancyMaxActiveBlocksPerMultiprocessor(&per_cu, (const void*)mega_fwd, NWAVES * 64, LDS_BYTES) != hipSuccess || per_cu < 1) { fprintf(stderr, "kernel_launch: occupancy query reports %d workgroups per CU\n", per_cu); }
        (void)hipGetLastError();
        grid = cus;
    }
    if (grid < 0) return;
    if (hipMemsetAsync((char*)d_ws + WS_CTL, 0, CTL_ZERO_BYTES, stream) != hipSuccess) { fprintf(stderr, "kernel_launch: memset failed\n"); return; }
    Args a{};
    for (int i = 0; i < 17; ++i) a.in[i] = (const float*)d_in[i];
    a.out = (float*)d_out; a.ws = (unsigned char*)d_ws;
#ifndef MK_SPLIT
    a.ph_lo = 0; a.ph_hi = N_PHASES;
    hipLaunchKernelGGL(mega_fwd, dim3(grid), dim3(NWAVES * 64), LDS_BYTES, stream, a);
#else
    for (int p = 0; p < N_PHASES; ++p) { a.ph_lo = p; a.ph_hi = p + 1; hipLaunchKernelGGL(mega_fwd, dim3(grid), dim3(NWAVES * 64), LDS_BYTES, stream, a); }
#endif
    const hipError_t le = hipPeekAtLastError();
    if (le != hipSuccess) fprintf(stderr, "kernel_launch: launch failed: %s\n", hipGetErrorName(le));
}
```
